# Optimizing an MI355X kernel written in HIP

```python
import math
import jax
import jax.numpy as jnp
from jax import lax
import numpy as np

D_MODEL = 2048
BATCH = 2
SEQ = 4096
DEPTH = 2

ROPE_THETA = 10000.0
ROPE_DIM = 64
Q_BLOCK = 128
NEG_INF = -1e30
LN_EPS = 1e-5
RMS_EPS = 1e-6

DIFF_HEADS = 8
DIFF_HEAD_DIM = 64
DIFF_V_DIM = 2 * DIFF_HEAD_DIM
MLA_HEADS = 8
MLA_Q_RANK = 512
MLA_KV_RANK = 256
MLA_NOPE_DIM = 128
MLA_ROPE_DIM = ROPE_DIM
MLA_V_DIM = 128
SWA_HEADS = 16
SWA_KV_HEADS = 4
SWA_GROUP = SWA_HEADS // SWA_KV_HEADS
SWA_HEAD_DIM = 64
WINDOW = 128

BRANCH_A_WIDTH = DIFF_HEADS * DIFF_V_DIM
BRANCH_B_WIDTH = MLA_HEADS * MLA_V_DIM
BRANCH_C_WIDTH = SWA_HEADS * SWA_HEAD_DIM

IN_SIZES = (
    2 * DIFF_HEADS * DIFF_HEAD_DIM,
    2 * DIFF_HEADS * DIFF_HEAD_DIM,
    DIFF_HEADS * DIFF_V_DIM,
    MLA_Q_RANK,
    MLA_KV_RANK,
    MLA_ROPE_DIM,
    SWA_HEADS * SWA_HEAD_DIM,
    SWA_KV_HEADS * SWA_HEAD_DIM,
    SWA_KV_HEADS * SWA_HEAD_DIM,
    3 * D_MODEL,
)
IN_WIDTH = sum(IN_SIZES)
IN_OFFSETS = tuple(int(o) for o in np.cumsum(IN_SIZES)[:-1])

N_EXPERTS = 16
N_GROUPS = 4
EXPERTS_PER_GROUP = N_EXPERTS // N_GROUPS
TOP_K = 2
EXPERT_HIDDEN = 512

DEEPNORM_ALPHA = (2 * DEPTH) ** 0.25
DEEPNORM_BETA = (8 * DEPTH) ** -0.25

kernel_name = 'hybrid_gated_diffattn_mla_swa_grouped_moe'


def layer_norm(x, g=None, b=None):
    xf = x.astype(jnp.float32)
    mu = xf.mean(-1, keepdims=True)
    var = jnp.square(xf - mu).mean(-1, keepdims=True)
    y = (xf - mu) * lax.rsqrt(var + LN_EPS)
    if g is not None:
        y = y * g.astype(jnp.float32) + b.astype(jnp.float32)
    return y.astype(x.dtype)


def rms_norm(x, g):
    xf = x.astype(jnp.float32)
    y = xf * lax.rsqrt(jnp.mean(xf * xf, -1, keepdims=True) + RMS_EPS) * g.astype(jnp.float32)
    return y.astype(x.dtype)


def modulate(xn, shift, scale):
    return xn * (1.0 + scale) + shift


def rope_tables(positions, dim):
    inv = ROPE_THETA ** (-jnp.arange(0, dim, 2, dtype=jnp.float32) / dim)
    ang = positions.astype(jnp.float32)[..., None] * inv
    return jnp.cos(ang), jnp.sin(ang)


def apply_rope(x, cos, sin):
    extra = x.ndim - 3
    cos = cos.reshape(cos.shape[:2] + (1,) * extra + cos.shape[2:])
    sin = sin.reshape(sin.shape[:2] + (1,) * extra + sin.shape[2:])
    x1, x2 = jnp.split(x.astype(jnp.float32), 2, axis=-1)
    out = jnp.concatenate([x1 * cos - x2 * sin, x2 * cos + x1 * sin], axis=-1)
    return out.astype(x.dtype)


def dense_attention(q, k, v, scale):
    B, M, H, S, dk = q.shape
    dv = v.shape[-1]
    nq = S // Q_BLOCK
    qb = q.reshape(B, M, H, nq, Q_BLOCK, dk).transpose(3, 0, 1, 2, 4, 5)

    def one_block(qi):
        s = jnp.einsum('bmhqd,bmhkd->bmhqk', qi, k).astype(jnp.float32) * scale
        p = jax.nn.softmax(s, axis=-1).astype(v.dtype)
        return jnp.einsum('bmhqk,bhkv->bmhqv', p, v)

    out = lax.map(one_block, qb)
    return out.transpose(1, 2, 3, 0, 4, 5).reshape(B, M, H, S, dv)


def diff_attention(q, k, v, cos, sin, lam_q, lam_k, subln_g, lam_init):
    B, S, _ = q.shape
    q = apply_rope(q.reshape(B, S, 2, DIFF_HEADS, DIFF_HEAD_DIM), cos, sin).transpose(0, 2, 3, 1, 4)
    k = apply_rope(k.reshape(B, S, 2, DIFF_HEADS, DIFF_HEAD_DIM), cos, sin).transpose(0, 2, 3, 1, 4)
    v = v.reshape(B, S, DIFF_HEADS, DIFF_V_DIM).transpose(0, 2, 1, 3)
    o = dense_attention(q, k, v, DIFF_HEAD_DIM ** -0.5)
    e = jnp.exp(jnp.sum(lam_q.astype(jnp.float32) * lam_k.astype(jnp.float32), axis=-1))
    lam = e[0] - e[1] + lam_init
    o = o[:, 0] - lam.astype(o.dtype) * o[:, 1]
    o = rms_norm(o, subln_g) * (1.0 - lam_init)
    return o.transpose(0, 2, 1, 3).reshape(B, S, BRANCH_A_WIDTH)


def latent_attention(cq, ckv, kr, cos, sin, q_norm, kv_norm, w_uq, w_ukv):
    B, S, _ = cq.shape
    q = (rms_norm(cq, q_norm) @ w_uq).reshape(B, S, MLA_HEADS, MLA_NOPE_DIM + MLA_ROPE_DIM)
    q = jnp.concatenate([q[..., :MLA_NOPE_DIM], apply_rope(q[..., MLA_NOPE_DIM:], cos, sin)], axis=-1)
    kv = (rms_norm(ckv, kv_norm) @ w_ukv).reshape(B, S, MLA_HEADS, MLA_NOPE_DIM + MLA_V_DIM)
    k_nope, v = kv[..., :MLA_NOPE_DIM], kv[..., MLA_NOPE_DIM:]
    k_rope = apply_rope(kr, cos, sin)
    k = jnp.concatenate(
        [k_nope, jnp.broadcast_to(k_rope[:, :, None, :], (B, S, MLA_HEADS, MLA_ROPE_DIM))], axis=-1)
    q = q.transpose(0, 2, 1, 3)[:, None]
    k = k.transpose(0, 2, 1, 3)[:, None]
    v = v.transpose(0, 2, 1, 3)
    o = dense_attention(q, k, v, (MLA_NOPE_DIM + MLA_ROPE_DIM) ** -0.5)[:, 0]
    return o.transpose(0, 2, 1, 3).reshape(B, S, BRANCH_B_WIDTH)


def window_attention(q, k, v, cos, sin, sink):
    B, S, _ = q.shape
    nb = S // WINDOW
    q = apply_rope(q.reshape(B, S, SWA_KV_HEADS, SWA_GROUP, SWA_HEAD_DIM), cos, sin)
    k = apply_rope(k.reshape(B, S, SWA_KV_HEADS, SWA_HEAD_DIM), cos, sin)
    v = v.reshape(B, S, SWA_KV_HEADS, SWA_HEAD_DIM)
    qb = q.reshape(B, nb, WINDOW, SWA_KV_HEADS, SWA_GROUP, SWA_HEAD_DIM)

    def band(t):
        tp = jnp.pad(t, ((0, 0), (WINDOW, WINDOW), (0, 0), (0, 0)))
        tp = tp.reshape(B, nb + 2, WINDOW, SWA_KV_HEADS, SWA_HEAD_DIM)
        return jnp.concatenate([tp[:, :-2], tp[:, 1:-1], tp[:, 2:]], axis=2)

    kb, vb = band(k), band(v)
    s = jnp.einsum('bnqgrd,bnkgd->bgrnqk', qb, kb).astype(jnp.float32) * (SWA_HEAD_DIM ** -0.5)
    blk = jnp.arange(nb)[:, None, None]
    qpos = blk * WINDOW + jnp.arange(WINDOW)[None, :, None]
    kpos = (blk - 1) * WINDOW + jnp.arange(3 * WINDOW)[None, None, :]
    valid = (jnp.abs(kpos - qpos) <= WINDOW) & (kpos >= 0) & (kpos < S)
    s = jnp.where(valid, s, NEG_INF)
    sink_logit = jnp.broadcast_to(
        sink.astype(jnp.float32).reshape(1, SWA_KV_HEADS, SWA_GROUP, 1, 1, 1), s.shape[:-1] + (1,))
    p = jax.nn.softmax(jnp.concatenate([s, sink_logit], axis=-1), axis=-1)[..., :-1].astype(v.dtype)
    o = jnp.einsum('bgrnqk,bnkgd->bnqgrd', p, vb)
    return o.reshape(B, S, BRANCH_C_WIDTH)


def hybrid_mixer(h, cos, sin, lam_init, w_in, lam_q, lam_k, subln_g, q_norm, kv_norm, w_uq, w_ukv,
                 sink, w_a, w_b, w_c, w_o):
    proj = h @ w_in
    a_q, a_k, a_v, b_cq, b_ckv, b_kr, c_q, c_k, c_v, gates = jnp.split(proj, IN_OFFSETS, axis=-1)
    ya = diff_attention(a_q, a_k, a_v, cos, sin, lam_q, lam_k, subln_g, lam_init)
    yb = latent_attention(b_cq, b_ckv, b_kr, cos, sin, q_norm, kv_norm, w_uq, w_ukv)
    yc = window_attention(c_q, c_k, c_v, cos, sin, sink)
    g_a, g_b, g_c = jnp.split(jax.nn.sigmoid(gates), 3, axis=-1)
    y = g_a * (ya @ w_a) + g_b * (yb @ w_b) + g_c * (yc @ w_c)
    return y @ w_o


def grouped_moe(h, router_w, router_bias, w1, w3, w2):
    B, S, D = h.shape
    t = h.reshape(B * S, D)
    T = t.shape[0]
    scores = jax.nn.sigmoid((t @ router_w).astype(jnp.float32))
    biased = scores + router_bias.astype(jnp.float32)
    grouped = biased.reshape(T, N_GROUPS, EXPERTS_PER_GROUP)
    group_score = lax.top_k(grouped, TOP_K)[0].sum(-1)
    best = jnp.argmax(group_score, axis=-1)
    in_group = jnp.arange(N_GROUPS)[None, :] == best[:, None]
    masked = jnp.where(in_group[:, :, None], grouped, NEG_INF).reshape(T, N_EXPERTS)
    _, idx = lax.top_k(masked, TOP_K)
    w = jnp.take_along_axis(scores, idx, axis=-1)
    w = w / jnp.sum(w, axis=-1, keepdims=True)
    gate = jnp.einsum('tk,tke->te', w, jax.nn.one_hot(idx, N_EXPERTS, dtype=jnp.float32))
    hidden = jax.nn.silu(jnp.einsum('td,edf->tef', t, w1)) * jnp.einsum('td,edf->tef', t, w3)
    hidden = hidden * gate[:, :, None].astype(hidden.dtype)
    out = jnp.einsum('tef,efd->td', hidden, w2)
    return out.reshape(B, S, D)


def setup_inputs(seed: int = 0) -> dict:
    key = jax.random.key(seed)
    ks = iter(jax.random.split(key, 40))
    L, D = DEPTH, D_MODEL

    def nrm(shape, std):
        return std * jax.random.normal(next(ks), shape, jnp.float32)

    return {
        'x': nrm((BATCH, SEQ, D), 1.0),
        'c': nrm((BATCH, D), 1.0),
        'positions': jnp.broadcast_to(jnp.arange(SEQ, dtype=jnp.int32), (BATCH, SEQ)),
        'w_in': nrm((L, D, IN_WIDTH), D ** -0.5),
        'diff_lambda_q': nrm((L, 2, DIFF_HEAD_DIM), 0.1),
        'diff_lambda_k': nrm((L, 2, DIFF_HEAD_DIM), 0.1),
        'diff_subln': 1.0 + nrm((L, DIFF_V_DIM), 0.02),
        'mla_q_norm': 1.0 + nrm((L, MLA_Q_RANK), 0.02),
        'mla_kv_norm': 1.0 + nrm((L, MLA_KV_RANK), 0.02),
        'mla_w_uq': nrm((L, MLA_Q_RANK, MLA_HEADS * (MLA_NOPE_DIM + MLA_ROPE_DIM)), MLA_Q_RANK ** -0.5),
        'mla_w_ukv': nrm((L, MLA_KV_RANK, MLA_HEADS * (MLA_NOPE_DIM + MLA_V_DIM)), MLA_KV_RANK ** -0.5),
        'swa_sink': nrm((L, SWA_HEADS), 1.0),
        'w_branch_a': nrm((L, BRANCH_A_WIDTH, D), DEEPNORM_BETA * BRANCH_A_WIDTH ** -0.5),
        'w_branch_b': nrm((L, BRANCH_B_WIDTH, D), DEEPNORM_BETA * BRANCH_B_WIDTH ** -0.5),
        'w_branch_c': nrm((L, BRANCH_C_WIDTH, D), DEEPNORM_BETA * BRANCH_C_WIDTH ** -0.5),
        'w_out': nrm((L, D, D), DEEPNORM_BETA * D ** -0.5),
        'w_ada': nrm((L, D, 6 * D), 0.5 * D ** -0.5),
        'b_ada': nrm((L, 6 * D), 0.1),
        'ln_mix_g': 1.0 + nrm((L, D), 0.02),
        'ln_mix_b': nrm((L, D), 0.02),
        'ln_ffn_g': 1.0 + nrm((L, D), 0.02),
        'ln_ffn_b': nrm((L, D), 0.02),
        'router_w': nrm((D, N_EXPERTS), D ** -0.5),
        'router_bias': nrm((N_EXPERTS,), 0.01),
        'expert_w1': nrm((L, N_EXPERTS, D, EXPERT_HIDDEN), D ** -0.5),
        'expert_w3': nrm((L, N_EXPERTS, D, EXPERT_HIDDEN), D ** -0.5),
        'expert_w2': nrm((L, N_EXPERTS, EXPERT_HIDDEN, D), DEEPNORM_BETA * EXPERT_HIDDEN ** -0.5),
    }


def reference(x, c, positions, w_in, diff_lambda_q, diff_lambda_k, diff_subln, mla_q_norm, mla_kv_norm,
              mla_w_uq, mla_w_ukv, swa_sink, w_branch_a, w_branch_b, w_branch_c, w_out, w_ada, b_ada,
              ln_mix_g, ln_mix_b, ln_ffn_g, ln_ffn_b, router_w, router_bias, expert_w1, expert_w3,
              expert_w2):
    cos, sin = rope_tables(positions, ROPE_DIM)
    c_act = jax.nn.silu(c)
    for l in range(DEPTH):
        mod = (c_act @ w_ada[l] + b_ada[l])[:, None, :]
        sh1, sc1, g1, sh2, sc2, g2 = jnp.split(mod, 6, axis=-1)
        lam_init = 0.8 - 0.6 * math.exp(-0.3 * l)
        h = modulate(layer_norm(x), sh1, sc1)
        y = hybrid_mixer(h, cos, sin, lam_init, w_in[l], diff_lambda_q[l], diff_lambda_k[l], diff_subln[l],
                         mla_q_norm[l], mla_kv_norm[l], mla_w_uq[l], mla_w_ukv[l], swa_sink[l],
                         w_branch_a[l], w_branch_b[l], w_branch_c[l], w_out[l])
        x = layer_norm(DEEPNORM_ALPHA * x + g1 * y, ln_mix_g[l], ln_mix_b[l])
        h = modulate(layer_norm(x), sh2, sc2)
        y = grouped_moe(h, router_w, router_bias, expert_w1[l], expert_w3[l], expert_w2[l])
        x = layer_norm(DEEPNORM_ALPHA * x + g2 * y, ln_ffn_g[l], ln_ffn_b[l])
    return x
```

```cpp
#include <hip/hip_runtime.h>
#include <cstdio>
#include <cstdint>

#ifndef MK_PER_PHASE
#define MK_PER_PHASE 0
#endif
#ifndef MK_FP8
#define MK_FP8 31
#endif
#ifndef MK_F8_RESCALE
#define MK_F8_RESCALE 0.015625f
#endif
#ifndef MK_F8_NOSCALE
#define MK_F8_NOSCALE 0
#endif
#ifndef MK_PHASE_MASK
#define MK_PHASE_MASK 0xFFFFu
#endif
#define PHEN(k) (((MK_PHASE_MASK) >> (k)) & 1u)
#ifndef MK_REPEAT
#define MK_REPEAT 0u
#endif
#define REP(k) for (int rep_ = 0; rep_ < 1 + (int)(((MK_REPEAT) >> (k)) & 1u); ++rep_)

#define GAS __attribute__((address_space(1)))
#define LAS __attribute__((address_space(3)))
typedef unsigned short bf16_t;
typedef short bf16x8 __attribute__((ext_vector_type(8)));
typedef short s16x4 __attribute__((ext_vector_type(4)));
typedef float f32x2 __attribute__((ext_vector_type(2)));
typedef float f32x4 __attribute__((ext_vector_type(4)));
typedef float f32x16 __attribute__((ext_vector_type(16)));
typedef unsigned u32x2 __attribute__((ext_vector_type(2)));
typedef unsigned u32x4 __attribute__((ext_vector_type(4)));

constexpr int DM = 2048, NB = 2, SEQ = 4096, T = NB * SEQ, DEPTH = 2;
constexpr int NPROJ = 11776;
constexpr int IN_WIDTH = 11584;
constexpr int OFF_AQ = 0, OFF_AK = 1024, OFF_AV = 2048, OFF_CQ = 3072, OFF_CKV = 3584, OFF_KR = 3840, OFF_SWQ = 3904, OFF_SWK = 4928, OFF_SWV = 5184, OFF_GATE = 5440;
constexpr int NEXP = 16, EH = 512;
constexpr float LN_EPS = 1e-5f, RMS_EPS = 1e-6f;
constexpr float ALPHA = 1.4142135623730951f;
constexpr int MAXROWS = 20480;
constexpr bool F8P = (MK_FP8 & 1) != 0, F8M = (MK_FP8 & 2) != 0, F8B = (MK_FP8 & 4) != 0, F8D = (MK_FP8 & 8) != 0, F8U = (MK_FP8 & 16) != 0;
constexpr float S_C = 16.f;
constexpr float S_YA = 2.f, S_YB = 32.f, S_YC = 16.f, S_Y = 16.f, S_HID = 16.f;
#ifndef MK_PV8
#define MK_PV8 7
#endif
constexpr bool PV8A = (MK_PV8 & 1) != 0, PV8B = (MK_PV8 & 2) != 0, PV8C = (MK_PV8 & 4) != 0;
#ifndef MK_QK8
#define MK_QK8 3
#endif
constexpr bool QK8A = (MK_QK8 & 1) != 0 && PV8A, QK8B = (MK_QK8 & 2) != 0 && PV8B;
constexpr float S_QK = 16.f;
#ifndef MK_GATE8
#define MK_GATE8 1
#endif
constexpr bool GATE8 = MK_GATE8 != 0 && F8B;
constexpr float S_V = 16.f;
constexpr float PV8_LOG2S = 4.5849625f, PV8_SCALE = 24.0f, PV8_THR = 4.0f;
constexpr int HROWB = F8P ? 2048 : 4096, HSROWB = F8M ? 2048 : 4096;

constexpr size_t MiB = 1u << 20;
constexpr size_t WS_CTL = 0, CTL_ZERO_BYTES = 1 * MiB;
constexpr size_t WS_MOD = 1 * MiB, WS_COS = 2 * MiB, WS_SIN = 3 * MiB, WS_ROUTE = 4 * MiB, WS_ROWIDX = 4 * MiB + 256 * 1024, WS_GATEW = 4 * MiB + 512 * 1024,
                 WS_SSQQ = 5 * MiB, WS_SSQK = 5 * MiB + 512 * 1024, WS_RT8 = 5 * MiB + 768 * 1024;
constexpr size_t WS_W = 6 * MiB, W_STRIDE = 165 * MiB;
constexpr size_t WO_WIN = 0, WO_WUQ = 46 * MiB, WO_WUKV = 47 * MiB + 512 * 1024, WO_WABC = 48 * MiB + 512 * 1024, WO_WO = 60 * MiB + 512 * 1024, WO_W13 = 68 * MiB + 512 * 1024,
                 WO_W2 = 132 * MiB + 512 * 1024;
constexpr size_t WS_XCUR = 336 * MiB, WS_H = 400 * MiB, WS_U = 432 * MiB, WS_ARENA = 496 * MiB;
constexpr size_t AR_AQ = 0, AR_AK = 16 * MiB, AR_AV = 32 * MiB, AR_CQ = 48 * MiB, AR_CKV = 56 * MiB, AR_SWQ = 60 * MiB, AR_SWK = 76 * MiB, AR_SWV = 80 * MiB, AR_GATES = 84 * MiB,
                 AR_QM = 180 * MiB, AR_KM = 204 * MiB, AR_VM = 228 * MiB, AR_YABC = 244 * MiB, AR_Y = 292 * MiB, AR_SCR = 324 * MiB, AR_END = 356 * MiB;
constexpr size_t AR_HS = 0, AR_HID = 80 * MiB, AR_OS = 100 * MiB;
constexpr size_t WS_END = WS_ARENA + AR_END;
constexpr int CW_BAR = 4096, CW_CNT = 16384;

constexpr int RING_BYTES = 131072, LDSCTL_OFF = 139264, LDS_BYTES = 147456;
constexpr int L_MISC = LDSCTL_OFF;
constexpr int L_BASE = LDSCTL_OFF + 256;
constexpr int L_TILEEXP = LDSCTL_OFF + 512;
constexpr int L_ROWTOK = RING_BYTES;
constexpr int L_ROWGW = RING_BYTES + 2048;

typedef float f32x2_cv __attribute__((ext_vector_type(2))); typedef __bf16 bf16x2_cv __attribute__((ext_vector_type(2)));
__device__ __forceinline__ unsigned cvt_pk_bf16(float lo, float hi) { const f32x2_cv v = {lo, hi}; const bf16x2_cv b = __builtin_convertvector(v, bf16x2_cv); return __builtin_bit_cast(unsigned, b); }
__device__ __forceinline__ u32x2 pk_bf4(f32x4 v) { u32x2 w; w.x = cvt_pk_bf16(v[0], v[1]); w.y = cvt_pk_bf16(v[2], v[3]); return w; }
__device__ __forceinline__ unsigned pack4_fp8(float a, float b, float c, float d) { int w = 0; w = __builtin_amdgcn_cvt_pk_fp8_f32(a, b, w, false); w = __builtin_amdgcn_cvt_pk_fp8_f32(c, d, w, true); return (unsigned)w; }
__device__ __forceinline__ float clamp8(float x) { return __builtin_amdgcn_fmed3f(x, -448.f, 448.f); }
__device__ __forceinline__ unsigned pack4_fp8s(float a, float b, float c, float d, float s) { return pack4_fp8(clamp8(a * s), clamp8(b * s), clamp8(c * s), clamp8(d * s)); }
__device__ __forceinline__ unsigned char fp8_byte(float x) { return (unsigned char)((unsigned)__builtin_amdgcn_cvt_pk_fp8_f32(clamp8(x), 0.f, 0, false) & 0xffu); }
__device__ __forceinline__ unsigned pack4_u8(float a, float b, float c, float d) { unsigned w = 0; w = __builtin_amdgcn_cvt_pk_u8_f32(a, 0, w); w = __builtin_amdgcn_cvt_pk_u8_f32(b, 1, w); w = __builtin_amdgcn_cvt_pk_u8_f32(c, 2, w); w = __builtin_amdgcn_cvt_pk_u8_f32(d, 3, w); return w; }
__device__ __forceinline__ float gate8(float g) { return __builtin_amdgcn_fmed3f(g * 255.0f, 1.0f, 255.0f); }
__device__ __forceinline__ float ub0(unsigned w) { return (float)(w & 0xffu); }
__device__ __forceinline__ float ub1(unsigned w) { return (float)((w >> 8) & 0xffu); }
__device__ __forceinline__ float ub2(unsigned w) { return (float)((w >> 16) & 0xffu); }
__device__ __forceinline__ float ub3(unsigned w) { return (float)(w >> 24); }
__device__ __forceinline__ f32x4 ld_bf4(const void* p) { const u32x2 w = *(const u32x2*)p; f32x4 r; r[0] = __uint_as_float(w.x << 16); r[1] = __uint_as_float(w.x & 0xffff0000u); r[2] = __uint_as_float(w.y << 16); r[3] = __uint_as_float(w.y & 0xffff0000u); return r; }
__device__ __forceinline__ f32x4 up_bf4(u32x2 w) { f32x4 r; r[0] = __uint_as_float(w.x << 16); r[1] = __uint_as_float(w.x & 0xffff0000u); r[2] = __uint_as_float(w.y << 16); r[3] = __uint_as_float(w.y & 0xffff0000u); return r; }
__device__ __forceinline__ float bf2f(unsigned short b) { return __uint_as_float(((unsigned)b) << 16); }
__device__ __forceinline__ float bflo(unsigned w) { return __uint_as_float(w << 16); }
__device__ __forceinline__ float bfhi(unsigned w) { return __uint_as_float(w & 0xffff0000u); }
__device__ __forceinline__ float xor16_sum(float x) { auto r = __builtin_amdgcn_permlane16_swap(__float_as_uint(x), __float_as_uint(x), false, false); return __uint_as_float(r[0]) + __uint_as_float(r[1]); }
__device__ __forceinline__ float xor32_sum(float x) { auto r = __builtin_amdgcn_permlane32_swap(__float_as_uint(x), __float_as_uint(x), false, false); return __uint_as_float(r[0]) + __uint_as_float(r[1]); }
template <int CTRL> __device__ __forceinline__ float dpp_f(float x) { return __int_as_float(__builtin_amdgcn_update_dpp(0, __float_as_int(x), CTRL, 0xF, 0xF, false)); }
__device__ __forceinline__ float row16_sum(float v) { v += dpp_f<0xB1>(v); v += dpp_f<0x4E>(v); v += dpp_f<0x141>(v); v += dpp_f<0x140>(v); return v; }
#ifndef MK_SHFL_SUM
#define MK_SHFL_SUM 0
#endif
#if MK_SHFL_SUM
__device__ __forceinline__ float wave_sum(float v) {
#pragma unroll
    for (int o = 1; o < 64; o <<= 1) v += __shfl_xor(v, o);
    return v;
}
#else
__device__ __forceinline__ float wave_sum(float v) { return xor32_sum(xor16_sum(row16_sum(v))); }
#endif
__device__ __forceinline__ float sigmoidf_(float x) { return __builtin_amdgcn_rcpf(1.0f + __builtin_amdgcn_exp2f(-1.4426950408889634f * x)); }
__device__ __forceinline__ int opaque_lane() { int t; asm volatile("v_mbcnt_lo_u32_b32 %0, -1, 0\n\tv_mbcnt_hi_u32_b32 %0, -1, %0" : "=v"(t)); return t; }
__device__ __forceinline__ int opaque_tid(int wv) { return opaque_lane() + wv * 64; }
template <class Tp> __device__ __forceinline__ GAS Tp* opaque_ptr(Tp* p) { GAS Tp* g = (GAS Tp*)p; asm volatile("" : "+v"(g)); return g; }
#define LDS_WAIT() asm volatile("s_waitcnt lgkmcnt(0)" ::: "memory")
#define VM_WAIT() asm volatile("s_waitcnt vmcnt(0)" ::: "memory")

#define XB_TMO      128
#define XB_XCNT(j)  (256  + 64 * (j))
#define XB_XSUB(j)  (1280 + 64 * (j))
#define XB_XGEN(j)  (2304 + 64 * (j))
#define XB_TOP      3328
#define XB_TOPGEN   3392
#define XCD_BAR_WORDS 3456
#define XB_SPIN_CAP (1u << 18)
__device__ __forceinline__ unsigned xb_ld(unsigned* p)              { return __hip_atomic_load(p, __ATOMIC_RELAXED, __HIP_MEMORY_SCOPE_AGENT); }
__device__ __forceinline__ unsigned xb_add(unsigned* p, unsigned v) { return __hip_atomic_fetch_add(p, v, __ATOMIC_RELAXED, __HIP_MEMORY_SCOPE_AGENT); }
__device__ __forceinline__ unsigned xb_xcc_id() { return (unsigned)__builtin_amdgcn_s_getreg((3 << 11) | 20) & 0xFu; }
#define XB_SPIN(cond, bar) do { unsigned _sp = 0; while (cond) { __builtin_amdgcn_s_sleep(1); \
    if ((++_sp & 255u) == 0u) { if (xb_ld(&(bar)[XB_TMO])) break; if (_sp > XB_SPIN_CAP) { atomicAdd(&(bar)[XB_TMO], 1u); break; } } } } while (0)
struct XcdBarrier { unsigned* bar; unsigned x; volatile LAS unsigned* st; };
__device__ __forceinline__ XcdBarrier xcd_barrier_post(unsigned* bar, volatile LAS unsigned* st) {
    XcdBarrier b; b.bar = bar; b.x = xb_xcc_id(); b.st = st;
    if (threadIdx.x == 0) (void)xb_add(&bar[XB_XCNT(b.x)], 1u);
    return b;
}
__device__ __forceinline__ void xcd_barrier_complete(unsigned* bar, unsigned x, unsigned& nloc, unsigned& nx) {
    const unsigned G = gridDim.x * gridDim.y * gridDim.z;
    unsigned sum, cnt, mine, sp = 0u;
    for (;;) {
        sum = 0u; cnt = 0u; mine = 0u;
#pragma unroll
        for (unsigned j = 0; j < 16; ++j) { const unsigned c = xb_ld(&bar[XB_XCNT(j)]); sum += c; cnt += (c > 0u) ? 1u : 0u; mine = (j == x) ? c : mine; }
        if (sum == G) break;
        __builtin_amdgcn_s_sleep(1);
        if ((++sp & 255u) == 0u) { if (xb_ld(&bar[XB_TMO])) break; if (sp > XB_SPIN_CAP) { atomicAdd(&bar[XB_TMO], 1u); break; } }
    }
    nloc = mine > 0u ? mine : 1u; nx = cnt > 0u ? cnt : 1u;
}
__device__ __forceinline__ void xcd_barrier(const XcdBarrier& b) {
    asm volatile("s_waitcnt vmcnt(0)" ::: "memory");
    __syncthreads();
    if (threadIdx.x == 0) {
        unsigned* bar = b.bar;
        __builtin_amdgcn_s_waitcnt(0);
        unsigned nloc = b.st[0], nx = b.st[1];
        if (nloc == 0u) { xcd_barrier_complete(bar, b.x, nloc, nx); b.st[0] = nloc; b.st[1] = nx; }
        const unsigned old = xb_add(&bar[XB_XSUB(b.x)], 1u);
        const unsigned gen = old / nloc;
        if (old + 1u == (gen + 1u) * nloc) {
            __builtin_amdgcn_fence(__ATOMIC_RELEASE, "agent");
            asm volatile("s_waitcnt vmcnt(0)" ::: "memory");
            const unsigned og = xb_add(&bar[XB_TOP], 1u);
            const unsigned tg = og / nx;
            if (og + 1u == (tg + 1u) * nx) xb_add(&bar[XB_TOPGEN], 1u);
            else XB_SPIN(xb_ld(&bar[XB_TOPGEN]) == tg, bar);
            __builtin_amdgcn_fence(__ATOMIC_ACQUIRE, "agent");
            xb_add(&bar[XB_XGEN(b.x)], 1u);
            asm volatile("s_waitcnt vmcnt(0)" ::: "memory");
        } else {
            XB_SPIN(xb_ld(&bar[XB_XGEN(b.x)]) == gen, bar);
            __builtin_amdgcn_fence(__ATOMIC_ACQUIRE, "agent");
            asm volatile("s_waitcnt vmcnt(0)" ::: "memory");
        }
    }
    __syncthreads();
}

namespace pg8 {
constexpr int BM = 256, BK = 64, HALF = 128, HTB = HALF * BK * 2, STAGE_BYTES = 8 * HTB, NXCD = 8, WGM = 8;
__host__ __device__ __forceinline__ int lds_byte(int r, int c) { const int st = (r >> 4) * 2 + (c >> 5), rr = r & 15, cc = c & 31, ob = rr * 64 + cc * 2; return st * 1024 + (ob ^ (((ob >> 9) & 1) << 5)); }
__host__ __device__ __forceinline__ void stage_rc(int b, int& R, int& C) { const int st = b / 1024, sb = b % 1024, swz = sb ^ (((sb >> 9) & 1) << 5); R = (st >> 1) * 16 + swz / 64; C = (st & 1) * 32 + (swz % 64) / 2; }
__host__ __device__ __forceinline__ int perm32(int rho) { const int n = rho >> 4, i = rho & 15; return 8 * (i >> 2) + 4 * n + (i & 3); }

struct Unit { int pm, pn, arow, brow, aux; };
struct Gemm { const bf16_t* A; const bf16_t* Bt; int K; float rs = 0.015625f; };

struct StaticOrder {
    int nM, nN, nwg, G, c;
    __device__ void init(int M, int N, int G_, int c_) { nM = M / BM; nN = N / BM; nwg = nM * nN; G = G_; c = c_; }
    __device__ bool tile(long L, Unit& u) const {
        int wgid = (int)L; { const int q = nwg / NXCD, r = nwg % NXCD, xcd = wgid % NXCD, off = wgid / NXCD; wgid = (xcd < r ? xcd * (q + 1) : r * (q + 1) + (xcd - r) * q) + off; }
        const int nig = WGM * nN, gid = wgid / nig, fm = gid * WGM, gsz = (nM - fm) < WGM ? (nM - fm) : WGM;
        u.pm = fm + ((wgid % nig) % gsz); u.pn = (wgid % nig) / gsz; return true;
    }
    __device__ bool next(int i, Unit& u) const {
        const long L = (long)i * G + c; if (L >= nwg) return false;
        tile(L, u); u.arow = u.pm * BM; u.brow = u.pn * BM; u.aux = 0; return true;
    }
};
struct BranchOrder : StaticOrder {
    int rowsA, rowsB;
    __device__ bool next(int i, Unit& u) const {
        if (i >= 3 || c >= nwg) return false;
        tile(c, u); u.arow = i * rowsA + u.pm * BM; u.brow = i * rowsB + u.pn * BM; u.aux = i; return true;
    }
};
struct GroupedOrder {
    const LAS int* tab; int nrt, npn, G, c, nbrows;
    __device__ bool next(int i, Unit& u) const {
        const int L = i * G + c; if (L >= nrt * npn) return false;
        u.pm = L / npn; u.pn = L % npn; const int e = __builtin_amdgcn_readfirstlane(tab[u.pm]); u.arow = u.pm * BM; u.brow = e * nbrows + u.pn * BM; u.aux = e; return true;
    }
};

struct GroupedGatherOrder : GroupedOrder {
    const LAS int* rowtab;
    __device__ bool next(int i, Unit& u) const { if (!GroupedOrder::next(i, u)) return false; u.aux |= (i & 1) << 8; u.arow = 0; return true; }
};
template <class S> struct sched_gathers { static constexpr bool value = false; };
template <> struct sched_gathers<GroupedGatherOrder> { static constexpr bool value = true; };
typedef int i32x4v __attribute__((ext_vector_type(4)));
typedef int i32x8v __attribute__((ext_vector_type(8)));
typedef int i32x16v __attribute__((ext_vector_type(16)));
typedef int i32x32v __attribute__((ext_vector_type(32)));
__host__ __device__ __forceinline__ void stage_rc8(int b, int& R, int& C) { const int st = b >> 10, rr = (b >> 6) & 15, c4 = ((b >> 4) & 3) ^ ((rr >> 3) & 1); R = (st >> 1) * 16 + rr; C = ((st & 1) * 4 + c4) * 8; }
template <class Epi, class Sched, bool F8 = false, bool ALIGN_EPI = true, bool SP2 = true>
__device__ __forceinline__ void gemm_phase(LAS unsigned char* lds, const Gemm g, const Sched& S, const Epi& E, int wv) {
    const int tid = opaque_tid(wv), wid = __builtin_amdgcn_readfirstlane(tid >> 6), lane = tid & 63, wr = wid >> 2, wc = wid & 3, fr = lane & 15, fq = lane >> 4;
    int K = g.K; asm volatile("" : "+s"(K));
    const int nt = K / BK;
    unsigned voffA[2], voffB[2];
#pragma unroll
    for (int i = 0; i < 2; ++i) { int R, C; if constexpr (F8) stage_rc8(tid * 16 + i * 8192, R, C); else stage_rc(tid * 16 + i * 8192, R, C); const int Rb = Epi::PERM ? ((R & ~31) + perm32(R & 31)) : R;
        voffA[i] = (unsigned)(R * K + C) * 2u; voffB[i] = (unsigned)(Rb * K + C) * 2u; }
    constexpr bool GATHER = sched_gathers<Sched>::value;
    const unsigned kstep = (unsigned)(BK * 2);
    const unsigned hstep = (unsigned)HALF * (unsigned)K * 2u;
    const unsigned hstepA = GATHER ? 0u : hstep;
    unsigned gcur[2][2]; int uin = 0;
#define PG8_GLOAD(dst, ui_) do { if constexpr (GATHER) { const LAS int* rt_ = S.rowtab + ((ui_) & 1) * 256; _Pragma("unroll") for (int h_ = 0; h_ < 2; ++h_) _Pragma("unroll") for (int i_ = 0; i_ < 2; ++i_) { \
        int R_, C_; stage_rc8(tid * 16 + i_ * 8192, R_, C_); dst[h_][i_] = (unsigned)rt_[R_ + HALF * h_] * (unsigned)K * 2u + (unsigned)C_ * 2u; } } } while (0)
#define PG8_STAGE_A(bufoff, soff, h, nx) do { if constexpr (GATHER) { unsigned vo_[2] = {gcur[h][0], gcur[h][1]}; \
        if (nx) { const LAS int* rt_ = S.rowtab + (uin & 1) * 256; _Pragma("unroll") for (int i_ = 0; i_ < 2; ++i_) { int R_, C_; stage_rc8(tid * 16 + i_ * 8192, R_, C_); vo_[i_] = (unsigned)rt_[R_ + HALF * (h)] * (unsigned)K * 2u + (unsigned)C_ * 2u; } } \
        PG8_STAGE(bufoff, rsA, soff, vo_); } else PG8_STAGE(bufoff, rsA, soff, voffA); } while (0)
    const unsigned rstep = (unsigned)K * 2u;
    const unsigned ldsw = (unsigned)wid * 1024u;
    const int x8 = (fr >> 3) & 1;
    const int f8base = (fq >> 1) * 1024 + fr * 64 + (fq & 1) * 32;
    const int aoff = F8 ? (wr * 8) * 1024 + f8base + 16 * x8 : lds_byte(wr * 64 + fr, fq * 8), boff = F8 ? (wc * 4) * 1024 + f8base + 16 * x8 : lds_byte(wc * 32 + fr, fq * 8);
    const int aoff1 = F8 ? (wr * 8) * 1024 + f8base + 16 - 16 * x8 : 0, boff1 = F8 ? (wc * 4) * 1024 + f8base + 16 - 16 * x8 : 0;
    constexpr int KOFF = 1024;
    const __amdgpu_buffer_rsrc_t rsA = __builtin_amdgcn_make_buffer_rsrc((void*)g.A, (short)0, 0xFFFFFFFF, 0x00020000);
    const __amdgpu_buffer_rsrc_t rsB = __builtin_amdgcn_make_buffer_rsrc((void*)g.Bt, (short)0, 0xFFFFFFFF, 0x00020000);
#define PG8_SA(b, h) (((b) * 2 + (h)) * HTB)
#define PG8_SB(b, h) ((4 + (b) * 2 + (h)) * HTB)
#define PG8_STAGE(bufoff, rs, soff, voff) do { _Pragma("unroll") for (int _i = 0; _i < 2; ++_i) \
        __builtin_amdgcn_raw_ptr_buffer_load_lds(rs, (LAS unsigned*)(lds + (bufoff) + ldsw + _i * 8192), 16, (voff)[_i], (soff), 0, 0); } while (0)
#define PG8_LD16(off) (*(const LAS i32x4v*)(lds + (off)))
#define PG8_LDA(dst, b, h) do { _Pragma("unroll") for (int m = 0; m < 4; ++m) { if constexpr (F8) dst##8[m] = __builtin_shufflevector(PG8_LD16(PG8_SA(b, h) + aoff + m * 2048), PG8_LD16(PG8_SA(b, h) + aoff1 + m * 2048), 0, 1, 2, 3, 4, 5, 6, 7); \
        else { _Pragma("unroll") for (int k = 0; k < 2; ++k) dst[m][k] = *(const LAS bf16x8*)(lds + PG8_SA(b, h) + aoff + m * 2048 + k * KOFF); } } } while (0)
#define PG8_LDB(dst, b, h) do { _Pragma("unroll") for (int n = 0; n < 2; ++n) { if constexpr (F8) dst##8[n] = __builtin_shufflevector(PG8_LD16(PG8_SB(b, h) + boff + n * 2048), PG8_LD16(PG8_SB(b, h) + boff1 + n * 2048), 0, 1, 2, 3, 4, 5, 6, 7); \
        else { _Pragma("unroll") for (int k = 0; k < 2; ++k) dst[n][k] = *(const LAS bf16x8*)(lds + PG8_SB(b, h) + boff + n * 2048 + k * KOFF); } } } while (0)
#define PG8_PIN(ai, bj) asm volatile("" : "+v"(acc[ai][bj][0][0]), "+v"(acc[ai][bj][0][1]), "+v"(acc[ai][bj][1][0]), "+v"(acc[ai][bj][1][1]), "+v"(acc[ai][bj][2][0]), "+v"(acc[ai][bj][2][1]), "+v"(acc[ai][bj][3][0]), "+v"(acc[ai][bj][3][1]))
#define PG8_MMA(ai, bj, At, Bt) do { __builtin_amdgcn_s_setprio(1); \
        if constexpr (F8) { PG8_PIN(ai, bj); _Pragma("unroll") for (int m = 0; m < 4; ++m) _Pragma("unroll") for (int n = 0; n < 2; ++n) { \
            if (MK_F8_NOSCALE) { _Pragma("unroll") for (int q = 0; q < 4; ++q) acc[ai][bj][m][n] = __builtin_amdgcn_mfma_f32_16x16x32_fp8_fp8( \
                (long)(((unsigned long long)(unsigned)Bt##8[n][2 * q + 1] << 32) | (unsigned)Bt##8[n][2 * q]), (long)(((unsigned long long)(unsigned)At##8[m][2 * q + 1] << 32) | (unsigned)At##8[m][2 * q]), acc[ai][bj][m][n], 0, 0, 0); } \
            else acc[ai][bj][m][n] = __builtin_amdgcn_mfma_scale_f32_16x16x128_f8f6f4(Bt##8[n], At##8[m], acc[ai][bj][m][n], 0, 0, 0, 0, 0, 0); }     PG8_PIN(ai, bj); } \
        else { _Pragma("unroll") for (int m = 0; m < 4; ++m) _Pragma("unroll") for (int n = 0; n < 2; ++n) _Pragma("unroll") for (int k = 0; k < 2; ++k) \
            acc[ai][bj][m][n] = __builtin_amdgcn_mfma_f32_16x16x32_bf16(Bt[n][k], At[m][k], acc[ai][bj][m][n], 0, 0, 0); } \
        __builtin_amdgcn_s_setprio(0); } while (0)
#define PG8_WAIT_V(n) asm volatile("s_waitcnt vmcnt(" #n ")" ::: "memory")
#define PG8_WAIT_L(n) asm volatile("s_waitcnt lgkmcnt(" #n ")" ::: "memory")
#define PG8_BAR __builtin_amdgcn_s_barrier()
#define PG8_SCHED __builtin_amdgcn_sched_barrier(0)
    Unit cur, nxt; int ui = 0;
    if (!S.next(0, cur)) return;
    f32x4 acc[2][2][4][2];
#pragma unroll
    for (int a = 0; a < 2; ++a)
#pragma unroll
        for (int b = 0; b < 2; ++b)
#pragma unroll
            for (int m = 0; m < 4; ++m)
#pragma unroll
                for (int n = 0; n < 2; ++n) acc[a][b][m][n] = (f32x4){0.f, 0.f, 0.f, 0.f};
    bf16x8 At[4][2], B0[2][2], B1[2][2];
    i32x8v At8[4], B08[2], B18[2];
    unsigned cA = (unsigned)cur.arow * rstep, cB = (unsigned)cur.brow * rstep;
    PG8_GLOAD(gcur, 0);
    if constexpr (SP2) {
        PG8_STAGE(PG8_SB(0, 0), rsB, cB, voffB); PG8_STAGE(PG8_SB(0, 1), rsB, cB + hstep, voffB); PG8_STAGE_A(PG8_SA(0, 0), cA, 0, false); PG8_STAGE_A(PG8_SA(0, 1), cA + hstepA, 1, false);
        if (wr == 1) PG8_BAR;
        PG8_WAIT_V(2); PG8_BAR;
        PG8_STAGE(PG8_SB(1, 0), rsB, cB + kstep, voffB); PG8_STAGE_A(PG8_SA(1, 0), cA + kstep, 0, false); PG8_STAGE(PG8_SB(1, 1), rsB, cB + hstep + kstep, voffB);
        PG8_WAIT_V(6); PG8_BAR;
    } else {
        PG8_STAGE(PG8_SB(0, 0), rsB, cB, voffB); PG8_STAGE_A(PG8_SA(0, 0), cA, 0, false); PG8_STAGE(PG8_SB(0, 1), rsB, cB + hstep, voffB); PG8_STAGE_A(PG8_SA(0, 1), cA + hstepA, 1, false);
        if (wr == 1) PG8_BAR;
        PG8_WAIT_V(4); PG8_BAR;
        PG8_STAGE(PG8_SB(1, 0), rsB, cB + kstep, voffB); PG8_STAGE_A(PG8_SA(1, 0), cA + kstep, 0, false); PG8_STAGE(PG8_SB(1, 1), rsB, cB + hstep + kstep, voffB);
        PG8_WAIT_V(6); PG8_BAR;
    }
    for (;;) {
        const bool has_next = S.next(ui + 1, nxt);
        const unsigned nA = has_next ? (unsigned)nxt.arow * rstep : cA, nB = has_next ? (unsigned)nxt.brow * rstep : cB;
        if constexpr (GATHER) uin = has_next ? ui + 1 : ui;
        for (int t = 0; t < nt; t += 2) {
            if constexpr (Epi::MIDSCALE) { if (t == 8 || t == 16) { const int ln_ = opaque_lane(); E.mid(acc, cur, t >> 3, wr, wc, ln_ & 15, ln_ >> 4); } }
            const bool last = (t == nt - 2);
            const unsigned a1 = cA + (unsigned)(t + 1) * kstep;
            const unsigned a2 = last ? nA : cA + (unsigned)(t + 2) * kstep, b2 = last ? nB : cB + (unsigned)(t + 2) * kstep;
            const unsigned a3 = a2 + kstep, b3 = b2 + kstep;
            if constexpr (SP2) {
            PG8_LDB(B0, 0, 0); PG8_LDB(B1, 0, 1); PG8_SCHED; PG8_LDA(At, 0, 0); PG8_STAGE_A(PG8_SA(1, 1), a1 + hstepA, 1, false);
            PG8_WAIT_V(8); PG8_WAIT_L(0); PG8_BAR; PG8_MMA(0, 0, At, B0); PG8_MMA(0, 1, At, B1); PG8_BAR; PG8_SCHED;
            PG8_LDA(At, 0, 1); PG8_STAGE(PG8_SB(0, 0), rsB, b2, voffB); PG8_STAGE(PG8_SB(0, 1), rsB, b2 + hstep, voffB); PG8_STAGE_A(PG8_SA(0, 0), a2, 0, last);
            PG8_WAIT_V(8); PG8_WAIT_L(0); PG8_BAR; PG8_MMA(1, 0, At, B0); PG8_MMA(1, 1, At, B1); PG8_BAR; PG8_SCHED;
            PG8_LDB(B0, 1, 0); PG8_LDB(B1, 1, 1); PG8_SCHED; PG8_LDA(At, 1, 0); PG8_STAGE_A(PG8_SA(0, 1), a2 + hstepA, 1, last);
            PG8_WAIT_V(8); PG8_WAIT_L(0); PG8_BAR; PG8_MMA(0, 0, At, B0); PG8_MMA(0, 1, At, B1); PG8_BAR; PG8_SCHED;
            PG8_LDA(At, 1, 1); PG8_STAGE(PG8_SB(1, 0), rsB, b3, voffB); PG8_STAGE(PG8_SB(1, 1), rsB, b3 + hstep, voffB); PG8_STAGE_A(PG8_SA(1, 0), a3, 0, last);
            PG8_WAIT_V(8); PG8_WAIT_L(0); PG8_BAR; PG8_MMA(1, 0, At, B0); PG8_MMA(1, 1, At, B1); PG8_BAR; PG8_SCHED;
            } else {
            PG8_LDB(B0, 0, 0); PG8_SCHED; PG8_LDA(At, 0, 0); PG8_STAGE_A(PG8_SA(1, 1), a1 + hstepA, 1, false);
            PG8_WAIT_L(8); PG8_BAR; PG8_WAIT_L(0); PG8_MMA(0, 0, At, B0); PG8_BAR; PG8_SCHED;
            PG8_LDB(B1, 0, 1); PG8_STAGE(PG8_SB(0, 0), rsB, b2, voffB);
            PG8_BAR; PG8_WAIT_L(0); PG8_MMA(0, 1, At, B1); PG8_BAR;
            PG8_LDA(At, 0, 1); PG8_STAGE_A(PG8_SA(0, 0), a2, 0, last);
            PG8_BAR; PG8_WAIT_L(0); PG8_MMA(1, 0, At, B0); PG8_BAR; PG8_SCHED;
            PG8_STAGE(PG8_SB(0, 1), rsB, b2 + hstep, voffB);
            PG8_WAIT_V(6); PG8_BAR; PG8_MMA(1, 1, At, B1); PG8_BAR;
            PG8_LDB(B0, 1, 0); PG8_SCHED; PG8_LDA(At, 1, 0); PG8_STAGE_A(PG8_SA(0, 1), a2 + hstepA, 1, last);
            PG8_WAIT_L(8); PG8_BAR; PG8_WAIT_L(0); PG8_MMA(0, 0, At, B0); PG8_BAR; PG8_SCHED;
            PG8_LDB(B1, 1, 1); PG8_STAGE(PG8_SB(1, 0), rsB, b3, voffB);
            PG8_BAR; PG8_WAIT_L(0); PG8_MMA(0, 1, At, B1); PG8_BAR;
            PG8_LDA(At, 1, 1); PG8_STAGE_A(PG8_SA(1, 0), a3, 0, last);
            PG8_BAR; PG8_WAIT_L(0); PG8_MMA(1, 0, At, B0); PG8_BAR; PG8_SCHED;
            PG8_STAGE(PG8_SB(1, 1), rsB, b3 + hstep, voffB);
            PG8_WAIT_V(6); PG8_BAR; PG8_MMA(1, 1, At, B1); PG8_BAR;
            }
        }
        if constexpr (ALIGN_EPI) { if (wr == 0) PG8_BAR; }
        if constexpr (F8) { const float rs_ = g.rs * E.unit_scale(cur);
#pragma unroll
            for (int a = 0; a < 2; ++a)
#pragma unroll
                for (int b = 0; b < 2; ++b)
#pragma unroll
                    for (int m = 0; m < 4; ++m)
#pragma unroll
                        for (int n = 0; n < 2; ++n) acc[a][b][m][n] = acc[a][b][m][n] * rs_; }
        { const int t_ = opaque_lane();
          E(acc, cur, wr, wc, t_ & 15, (t_ >> 4) & 3); }
        if (!has_next) break;
#pragma unroll
        for (int a = 0; a < 2; ++a)
#pragma unroll
            for (int b = 0; b < 2; ++b)
#pragma unroll
                for (int m = 0; m < 4; ++m)
#pragma unroll
                    for (int n = 0; n < 2; ++n) acc[a][b][m][n] = (f32x4){0.f, 0.f, 0.f, 0.f};
        cur = nxt; cA = nA; cB = nB; ++ui;
        PG8_GLOAD(gcur, ui);
        if constexpr (ALIGN_EPI) { if (wr == 1) PG8_BAR; }
    }
    PG8_WAIT_V(0);
    if constexpr (!ALIGN_EPI) { if (wr == 0) PG8_BAR; }
    PG8_BAR;
#undef PG8_SA
#undef PG8_GLOAD
#undef PG8_STAGE_A
#undef PG8_SB
#undef PG8_STAGE
#undef PG8_LDA
#undef PG8_LDB
#undef PG8_MMA
#undef PG8_PIN
#undef PG8_LD16
#undef PG8_WAIT_V
#undef PG8_WAIT_L
#undef PG8_BAR
#undef PG8_SCHED
}

__device__ __forceinline__ u32x4 pack8(f32x4 a, f32x4 b) { u32x4 w; w.x = cvt_pk_bf16(a[0], a[1]); w.y = cvt_pk_bf16(a[2], a[3]); w.z = cvt_pk_bf16(b[0], b[1]); w.w = cvt_pk_bf16(b[2], b[3]); return w; }
__device__ __forceinline__ void store_vt8(const f32x4 (&acc)[2][2][4][2], const Unit& u, int wr, int wc, int fr, int fq, unsigned char* VT, int hb, const float (&rs)[2][4], int rb0 = -1, int rb1 = -1) {
    const unsigned selA = (fr & 1) ? 0x07030501u : 0x02060004u, selB = (fr & 2) ? 0x07060302u : 0x01000504u;
    const int a4 = fr >> 2, iq = fr & 3, s64 = (u.pm * BM + wr * 64) & 4095;
#pragma unroll
    for (int ai = 0; ai < 2; ++ai)
#pragma unroll
        for (int m = 0; m < 4; ++m) { const int slot4 = (a4 & 1) * 32 + (m >> 1) * 16 + ((m & 1) * 2 + (a4 >> 1)) * 4; const float sc = rs[ai][m] * S_V;
#pragma unroll
            for (int bj = 0; bj < 2; ++bj) {
                unsigned w0 = pack4_fp8s(acc[ai][bj][m][0][0], acc[ai][bj][m][0][1], acc[ai][bj][m][0][2], acc[ai][bj][m][0][3], sc);
                unsigned w1 = pack4_fp8s(acc[ai][bj][m][1][0], acc[ai][bj][m][1][1], acc[ai][bj][m][1][2], acc[ai][bj][m][1][3], sc);
                { const unsigned p0 = (unsigned)__builtin_amdgcn_update_dpp(0, (int)w0, 0xB1, 0xF, 0xF, false), p1 = (unsigned)__builtin_amdgcn_update_dpp(0, (int)w1, 0xB1, 0xF, 0xF, false);
                  w0 = __builtin_amdgcn_perm(w0, p0, selA); w1 = __builtin_amdgcn_perm(w1, p1, selA); }
                { const unsigned p0 = (unsigned)__builtin_amdgcn_update_dpp(0, (int)w0, 0x4E, 0xF, 0xF, false), p1 = (unsigned)__builtin_amdgcn_update_dpp(0, (int)w1, 0x4E, 0xF, 0xF, false);
                  w0 = __builtin_amdgcn_perm(w0, p0, selB); w1 = __builtin_amdgcn_perm(w1, p1, selB); }
                const int vrow = (rb0 >= 0) ? ((bj ? rb1 : rb0) + iq) : ((hb + bj) * 128 + wc * 32 + 8 * fq + iq);
                unsigned char* d = VT + (size_t)vrow * 4096 + ((s64 + ai * HALF) & 4095) + slot4;
                *(unsigned*)d = w0; *(unsigned*)(d + 4 * 4096) = w1; } }
}
__device__ __forceinline__ void rope_pair_r(const f32x4 (&acc)[2][2][4][2], int ai, int m, f32x4 c0, f32x4 c1, f32x4 s0, f32x4 s1, float mul, u32x4& w1, u32x4& w2) {
    const f32x4 a0 = acc[ai][0][m][0] * mul, a1 = acc[ai][0][m][1] * mul, b0 = acc[ai][1][m][0] * mul, b1 = acc[ai][1][m][1] * mul;
    w1 = pack8(a0 * c0 - b0 * s0, a1 * c1 - b1 * s1);
    w2 = pack8(b0 * c0 + a0 * s0, b1 * c1 + a1 * s1);
}
__device__ __forceinline__ void rope_pair(const f32x4 (&acc)[2][2][4][2], int ai, int m, const float* cs, const float* sn, float mul, u32x4& w1, u32x4& w2) {
    const f32x4 c0 = *(const f32x4*)cs, c1 = *(const f32x4*)(cs + 4), s0 = *(const f32x4*)sn, s1 = *(const f32x4*)(sn + 4);
    const f32x4 a0 = acc[ai][0][m][0] * mul, a1 = acc[ai][0][m][1] * mul, b0 = acc[ai][1][m][0] * mul, b1 = acc[ai][1][m][1] * mul;
    w1 = pack8(a0 * c0 - b0 * s0, a1 * c1 - b1 * s1);
    w2 = pack8(b0 * c0 + a0 * s0, b1 * c1 + a1 * s1);
}

struct EpiProj {
    static constexpr bool PERM = true;
    static constexpr bool MIDSCALE = false;
    __device__ __forceinline__ float unit_scale(const Unit&) const { return 1.0f; }
    bf16_t *AQ, *AK, *AV, *CQ, *CKV, *SWQ, *SWK, *SWV, *GATES, *KM; float *SSQQ, *SSQK; const float *COS, *SIN;
    __device__ __forceinline__ void operator()(const f32x4 (&acc)[2][2][4][2], const Unit& u, int wr, int wc, int fr, int fq) const {
        const int pn = u.pn, row0 = u.pm * BM + wr * 64 + fr;
        if (pn < 8 || (pn >= 15 && pn <= 19)) {
            bf16_t* buf; int hb, nh;
            if (pn < 4) { buf = AQ; nh = 16; hb = pn * 4 + wc; } else if (pn < 8) { buf = AK; nh = 16; hb = (pn - 4) * 4 + wc; }
            else if (pn < 19) { buf = SWQ; nh = 16; hb = (pn - 15) * 4 + wc; } else { buf = SWK; nh = 4; hb = wc; }
            f32x4 cs[2][4];
            { const int t = row0; cs[0][0] = *(const f32x4*)(COS + (size_t)t * 32 + 8 * fq); cs[0][1] = *(const f32x4*)(COS + (size_t)t * 32 + 8 * fq + 4); cs[0][2] = *(const f32x4*)(SIN + (size_t)t * 32 + 8 * fq); cs[0][3] = *(const f32x4*)(SIN + (size_t)t * 32 + 8 * fq + 4); }
            asm volatile("" ::: "memory");
#pragma unroll
            for (int ai = 0; ai < 2; ++ai)
#pragma unroll
                for (int m = 0; m < 4; ++m) { const int k = ai * 4 + m, t = row0 + ai * HALF + m * 16, b = t >> 12, s = t & 4095;
                    if (k + 1 < 8) { const int tn = row0 + ((k + 1) >> 2) * HALF + ((k + 1) & 3) * 16;
                        cs[(k + 1) & 1][0] = *(const f32x4*)(COS + (size_t)tn * 32 + 8 * fq); cs[(k + 1) & 1][1] = *(const f32x4*)(COS + (size_t)tn * 32 + 8 * fq + 4);
                        cs[(k + 1) & 1][2] = *(const f32x4*)(SIN + (size_t)tn * 32 + 8 * fq); cs[(k + 1) & 1][3] = *(const f32x4*)(SIN + (size_t)tn * 32 + 8 * fq + 4); asm volatile("" ::: "memory"); }
                    if ((QK8A && pn < 8) || (PV8C && pn >= 15)) {
                        const f32x4 c0 = cs[k & 1][0], c1 = cs[k & 1][1], s0 = cs[k & 1][2], s1 = cs[k & 1][3], a0 = acc[ai][0][m][0], a1 = acc[ai][0][m][1], b0 = acc[ai][1][m][0], b1 = acc[ai][1][m][1];
                        const f32x4 x0 = a0 * c0 - b0 * s0, x1 = a1 * c1 - b1 * s1, y0 = b0 * c0 + a0 * s0, y1 = b1 * c1 + a1 * s1;
                        u32x2 v1, v2; v1.x = pack4_fp8s(x0[0], x0[1], x0[2], x0[3], S_QK); v1.y = pack4_fp8s(x1[0], x1[1], x1[2], x1[3], S_QK); v2.x = pack4_fp8s(y0[0], y0[1], y0[2], y0[3], S_QK); v2.y = pack4_fp8s(y1[0], y1[1], y1[2], y1[3], S_QK);
                        unsigned char* d8 = (unsigned char*)buf + ((size_t)(b * nh + hb) * SEQ + s) * 64 + 8 * fq;
                        *(u32x2*)d8 = v1; *(u32x2*)(d8 + 32) = v2; asm volatile("" ::: "memory");
                    } else {
                    u32x4 w1, w2; rope_pair_r(acc, ai, m, cs[k & 1][0], cs[k & 1][1], cs[k & 1][2], cs[k & 1][3], 1.0f, w1, w2);
                    bf16_t* d = buf + ((size_t)(b * nh + hb) * SEQ + s) * 64 + 8 * fq;
                    *(u32x4*)d = w1; *(u32x4*)(d + 32) = w2; asm volatile("" ::: "memory"); } }
        } else if (pn == 45) {
            if (wc == 0) {
#pragma unroll
                for (int ai = 0; ai < 2; ++ai)
#pragma unroll
                    for (int m = 0; m < 4; ++m) { const int t = row0 + ai * HALF + m * 16, b = t >> 12, s = t & 4095;
                        if (QK8B) { const float* cp = COS + (size_t)t * 32 + 8 * fq; const float* sp = SIN + (size_t)t * 32 + 8 * fq;
                            const f32x4 c0 = *(const f32x4*)cp, c1 = *(const f32x4*)(cp + 4), s0 = *(const f32x4*)sp, s1 = *(const f32x4*)(sp + 4), a0 = acc[ai][0][m][0], a1 = acc[ai][0][m][1], b0 = acc[ai][1][m][0], b1 = acc[ai][1][m][1];
                            const f32x4 x0 = a0 * c0 - b0 * s0, x1 = a1 * c1 - b1 * s1, y0 = b0 * c0 + a0 * s0, y1 = b1 * c1 + a1 * s1;
                            u32x2 v1, v2; v1.x = pack4_fp8s(x0[0], x0[1], x0[2], x0[3], S_QK); v1.y = pack4_fp8s(x1[0], x1[1], x1[2], x1[3], S_QK); v2.x = pack4_fp8s(y0[0], y0[1], y0[2], y0[3], S_QK); v2.y = pack4_fp8s(y1[0], y1[1], y1[2], y1[3], S_QK);
#pragma unroll
                            for (int h = 0; h < 8; ++h) { unsigned char* d8 = (unsigned char*)KM + ((size_t)(b * 8 + h) * SEQ + s) * 192 + 128 + 8 * fq; *(u32x2*)d8 = v1; *(u32x2*)(d8 + 32) = v2; }
                            asm volatile("" ::: "memory"); continue; }
                        u32x4 w1, w2; rope_pair(acc, ai, m, COS + (size_t)t * 32 + 8 * fq, SIN + (size_t)t * 32 + 8 * fq, 1.0f, w1, w2);
#pragma unroll
                        for (int h = 0; h < 8; ++h) { bf16_t* d = KM + ((size_t)(b * 8 + h) * SEQ + s) * 192 + 128 + 8 * fq; *(u32x4*)d = w1; *(u32x4*)(d + 32) = w2; } asm volatile("" ::: "memory"); }
            }
        } else if (pn >= 21) {
            const int col0 = (pn - 21) * BM + wc * 32 + 8 * fq;
#pragma unroll
            for (int ai = 0; ai < 2; ++ai)
#pragma unroll
                for (int m = 0; m < 4; ++m) { const int t = row0 + ai * HALF + m * 16; bf16_t* d = GATES + (size_t)t * 6144 + col0;
#pragma unroll
                    for (int bj = 0; bj < 2; ++bj) { f32x4 v0 = acc[ai][bj][m][0], v1 = acc[ai][bj][m][1];
#pragma unroll
                        for (int j = 0; j < 4; ++j) { v0[j] = sigmoidf_(v0[j]); v1[j] = sigmoidf_(v1[j]); }
                        if (GATE8) { u32x2 o8; o8.x = pack4_u8(gate8(v0[0]), gate8(v0[1]), gate8(v0[2]), gate8(v0[3])); o8.y = pack4_u8(gate8(v1[0]), gate8(v1[1]), gate8(v1[2]), gate8(v1[3]));
                            *(u32x2*)((unsigned char*)GATES + (size_t)t * 6144 + col0 + bj * HALF) = o8; }
                        else *(u32x4*)(d + bj * HALF) = pack8(v0, v1); } }
        } else if (PV8A && pn >= 8 && pn < 12) {
            const float one[2][4] = {{1.f, 1.f, 1.f, 1.f}, {1.f, 1.f, 1.f, 1.f}};
            store_vt8(acc, u, wr, wc, fr, fq, (unsigned char*)AV, ((u.pm * BM) >> 12) * 8 + (pn - 8) * 2, one);
        } else if (pn >= 8 && pn < 12) {
#pragma unroll
            for (int ai = 0; ai < 2; ++ai)
#pragma unroll
                for (int m = 0; m < 4; ++m) { const int t = row0 + ai * HALF + m * 16, b = t >> 12, s = t & 4095;
#pragma unroll
                    for (int bj = 0; bj < 2; ++bj) { bf16_t* d = AV + ((size_t)(b * 8 + (pn - 8) * 2 + bj) * SEQ + s) * 128 + wc * 32 + 8 * fq;
                        *(u32x4*)d = pack8(acc[ai][bj][m][0], acc[ai][bj][m][1]); } }
        } else if (PV8C && pn == 20) {
            const float one[2][4] = {{1.f, 1.f, 1.f, 1.f}, {1.f, 1.f, 1.f, 1.f}}; const int b = (u.pm * BM) >> 12;
            store_vt8(acc, u, wr, wc, fr, fq, (unsigned char*)SWV, 0, one, ((b * 4 + (wc >> 1)) * 64) + (wc & 1) * 32 + 8 * fq, ((b * 4 + 2 + (wc >> 1)) * 64) + (wc & 1) * 32 + 8 * fq);
        } else if (pn == 20) {
#pragma unroll
            for (int ai = 0; ai < 2; ++ai)
#pragma unroll
                for (int m = 0; m < 4; ++m) { const int t = row0 + ai * HALF + m * 16, b = t >> 12, s = t & 4095;
#pragma unroll
                    for (int bj = 0; bj < 2; ++bj) { bf16_t* d = SWV + ((size_t)(b * 4 + 2 * bj + (wc >> 1)) * SEQ + s) * 64 + (wc & 1) * 32 + 8 * fq;
                        *(u32x4*)d = pack8(acc[ai][bj][m][0], acc[ai][bj][m][1]); } }
        } else {
            const bool isq = pn < 14; bf16_t* buf = isq ? CQ : CKV; const int ld = isq ? 512 : 256, col0 = (isq ? (pn - 12) * BM : 0) + wc * 32 + 8 * fq;
#pragma unroll
            for (int ai = 0; ai < 2; ++ai)
#pragma unroll
                for (int m = 0; m < 4; ++m) { const int t = row0 + ai * HALF + m * 16; bf16_t* d = buf + (size_t)t * ld + col0; float ss = 0.f;
#pragma unroll
                    for (int bj = 0; bj < 2; ++bj) { const f32x4 v0 = acc[ai][bj][m][0], v1 = acc[ai][bj][m][1];
                        ss += (v0[0] * v0[0] + v0[1] * v0[1]) + (v0[2] * v0[2] + v0[3] * v0[3]) + (v1[0] * v1[0] + v1[1] * v1[1]) + (v1[2] * v1[2] + v1[3] * v1[3]);
                        if (F8U) { u32x2 o8; o8.x = pack4_fp8s(v0[0], v0[1], v0[2], v0[3], S_C); o8.y = pack4_fp8s(v1[0], v1[1], v1[2], v1[3], S_C); *(u32x2*)((unsigned char*)buf + (size_t)t * ld + col0 + bj * HALF) = o8; }
                        else *(u32x4*)(d + bj * HALF) = pack8(v0, v1); }
                    ss = xor32_sum(xor16_sum(ss));
                    if (fq == 0) { if (isq) SSQQ[(size_t)t * 8 + (pn - 12) * 4 + wc] = ss; else SSQK[(size_t)t * 4 + wc] = ss; } }
        }
    }
};
struct EpiUq {
    static constexpr bool PERM = true;
    static constexpr bool MIDSCALE = false;
    __device__ __forceinline__ float unit_scale(const Unit&) const { return 1.0f; }
    bf16_t* QM; const float *SSQQ, *COS, *SIN;
    __device__ __forceinline__ void operator()(const f32x4 (&acc)[2][2][4][2], const Unit& u, int wr, int wc, int fr, int fq) const {
        const int pn = u.pn, row0 = u.pm * BM + wr * 64 + fr;
#pragma unroll
        for (int ai = 0; ai < 2; ++ai)
#pragma unroll
            for (int m = 0; m < 4; ++m) { const int t = row0 + ai * HALF + m * 16, b = t >> 12, s = t & 4095;
                const f32x4 q0 = *(const f32x4*)(SSQQ + (size_t)t * 8), q1 = *(const f32x4*)(SSQQ + (size_t)t * 8 + 4);
                const float ssq = ((q0[0] + q0[1]) + (q0[2] + q0[3])) + ((q1[0] + q1[1]) + (q1[2] + q1[3]));
                const float r = 1.0f / sqrtf(ssq * (1.0f / 512.0f) + RMS_EPS);
                if (QK8B) {
                    unsigned char* Q8 = (unsigned char*)QM;
                    if (pn < 4) {
#pragma unroll
                        for (int bj = 0; bj < 2; ++bj) { const f32x4 v0 = acc[ai][bj][m][0], v1 = acc[ai][bj][m][1]; u32x2 o8; o8.x = pack4_fp8s(v0[0], v0[1], v0[2], v0[3], r * S_QK); o8.y = pack4_fp8s(v1[0], v1[1], v1[2], v1[3], r * S_QK);
                            *(u32x2*)(Q8 + ((size_t)(b * 8 + 2 * pn + bj) * SEQ + s) * 192 + wc * 32 + 8 * fq) = o8; }
                    } else { const float* cp = COS + (size_t)t * 32 + 8 * fq; const float* sp = SIN + (size_t)t * 32 + 8 * fq;
                        const f32x4 c0 = *(const f32x4*)cp, c1 = *(const f32x4*)(cp + 4), s0 = *(const f32x4*)sp, s1 = *(const f32x4*)(sp + 4), a0 = acc[ai][0][m][0], a1 = acc[ai][0][m][1], b0 = acc[ai][1][m][0], b1 = acc[ai][1][m][1];
                        const f32x4 x0 = a0 * c0 - b0 * s0, x1 = a1 * c1 - b1 * s1, y0 = b0 * c0 + a0 * s0, y1 = b1 * c1 + a1 * s1;
                        u32x2 v1, v2; v1.x = pack4_fp8s(x0[0], x0[1], x0[2], x0[3], r * S_QK); v1.y = pack4_fp8s(x1[0], x1[1], x1[2], x1[3], r * S_QK); v2.x = pack4_fp8s(y0[0], y0[1], y0[2], y0[3], r * S_QK); v2.y = pack4_fp8s(y1[0], y1[1], y1[2], y1[3], r * S_QK);
                        unsigned char* d8 = Q8 + ((size_t)(b * 8 + 4 * (pn - 4) + wc) * SEQ + s) * 192 + 128 + 8 * fq;
                        *(u32x2*)d8 = v1; *(u32x2*)(d8 + 32) = v2; }
                } else if (pn < 4) {
#pragma unroll
                    for (int bj = 0; bj < 2; ++bj) { bf16_t* d = QM + ((size_t)(b * 8 + 2 * pn + bj) * SEQ + s) * 192 + wc * 32 + 8 * fq;
                        *(u32x4*)d = pack8(acc[ai][bj][m][0] * r, acc[ai][bj][m][1] * r); }
                } else {
                    u32x4 w1, w2; rope_pair(acc, ai, m, COS + (size_t)t * 32 + 8 * fq, SIN + (size_t)t * 32 + 8 * fq, r, w1, w2);
                    bf16_t* d = QM + ((size_t)(b * 8 + 4 * (pn - 4) + wc) * SEQ + s) * 192 + 128 + 8 * fq;
                    *(u32x4*)d = w1; *(u32x4*)(d + 32) = w2;
                } }
    }
};
struct EpiUkv {
    static constexpr bool PERM = true;
    static constexpr bool MIDSCALE = false;
    __device__ __forceinline__ float unit_scale(const Unit&) const { return 1.0f; }
    bf16_t *KM, *VM; const float* SSQK;
    __device__ __forceinline__ void operator()(const f32x4 (&acc)[2][2][4][2], const Unit& u, int wr, int wc, int fr, int fq) const {
        const int pn = u.pn, row0 = u.pm * BM + wr * 64 + fr; bf16_t* base = (pn < 4) ? KM : VM; const int ld = (pn < 4) ? 192 : 128;
        float rs[2][4];
#pragma unroll
        for (int ai = 0; ai < 2; ++ai)
#pragma unroll
            for (int m = 0; m < 4; ++m) { const f32x4 q0 = *(const f32x4*)(SSQK + (size_t)(row0 + ai * HALF + m * 16) * 4);
                rs[ai][m] = 1.0f / sqrtf(((q0[0] + q0[1]) + (q0[2] + q0[3])) * (1.0f / 256.0f) + RMS_EPS); }
        asm volatile("" ::: "memory");
        if (PV8B && pn >= 4) { store_vt8(acc, u, wr, wc, fr, fq, (unsigned char*)VM, ((u.pm * BM) >> 12) * 8 + 2 * (pn & 3), rs); return; }
#pragma unroll
        for (int ai = 0; ai < 2; ++ai)
#pragma unroll
            for (int m = 0; m < 4; ++m) { const int t = row0 + ai * HALF + m * 16, b = t >> 12, s = t & 4095;
                const float r = rs[ai][m];
#pragma unroll
                for (int bj = 0; bj < 2; ++bj) {
                    if (QK8B && pn < 4) { const f32x4 v0 = acc[ai][bj][m][0], v1 = acc[ai][bj][m][1]; u32x2 o8; o8.x = pack4_fp8s(v0[0], v0[1], v0[2], v0[3], r * S_QK); o8.y = pack4_fp8s(v1[0], v1[1], v1[2], v1[3], r * S_QK);
                        *(u32x2*)((unsigned char*)KM + ((size_t)(b * 8 + 2 * (pn & 3) + bj) * SEQ + s) * 192 + wc * 32 + 8 * fq) = o8; continue; }
                    bf16_t* d = base + ((size_t)(b * 8 + 2 * (pn & 3) + bj) * SEQ + s) * ld + wc * 32 + 8 * fq;
                    *(u32x4*)d = pack8(acc[ai][bj][m][0] * r, acc[ai][bj][m][1] * r); } }
    }
};
struct EpiBranch {
    static constexpr bool PERM = true, MIDSCALE = F8B;
    __device__ __forceinline__ float unit_scale(const Unit&) const { return 1.0f; }
    bf16_t* Y; const bf16_t* GATES; unsigned char* Y8;
    __device__ __forceinline__ void mid(f32x4 (&acc)[2][2][4][2], const Unit& u, int which, int wr, int wc, int fr, int fq) const {
        const int row0 = u.pm * BM + wr * 64 + fr, col0 = u.pn * BM + wc * 32 + 8 * fq;
        const float sc = (which == 1) ? S_YB / S_YA : S_YC / S_YB;
        if constexpr (GATE8) {
            const unsigned char* gbase = (const unsigned char*)GATES + (size_t)row0 * 6144 + (which - 1) * 2048 + col0;
#pragma unroll
            for (int ai = 0; ai < 2; ++ai) {
                u32x2 P[4][2], Q[4][2];
#pragma unroll
                for (int m = 0; m < 4; ++m)
#pragma unroll
                    for (int bj = 0; bj < 2; ++bj) { const unsigned char* gp = gbase + (size_t)(ai * HALF + m * 16) * 6144 + bj * HALF; P[m][bj] = *(const u32x2*)gp; Q[m][bj] = *(const u32x2*)(gp + 2048); }
#pragma unroll
                for (int m = 0; m < 4; ++m)
#pragma unroll
                    for (int bj = 0; bj < 2; ++bj) { const u32x2 p = P[m][bj], q = Q[m][bj];
                        f32x4 r0, r1;
                        r0[0] = ub0(p.x) * __builtin_amdgcn_rcpf(ub0(q.x)); r0[1] = ub1(p.x) * __builtin_amdgcn_rcpf(ub1(q.x)); r0[2] = ub2(p.x) * __builtin_amdgcn_rcpf(ub2(q.x)); r0[3] = ub3(p.x) * __builtin_amdgcn_rcpf(ub3(q.x));
                        r1[0] = ub0(p.y) * __builtin_amdgcn_rcpf(ub0(q.y)); r1[1] = ub1(p.y) * __builtin_amdgcn_rcpf(ub1(q.y)); r1[2] = ub2(p.y) * __builtin_amdgcn_rcpf(ub2(q.y)); r1[3] = ub3(p.y) * __builtin_amdgcn_rcpf(ub3(q.y));
                        acc[ai][bj][m][0] = acc[ai][bj][m][0] * (r0 * sc); acc[ai][bj][m][1] = acc[ai][bj][m][1] * (r1 * sc); }
                asm volatile("" ::: "memory"); }
            return; }
        const bf16_t* gbase = GATES + (size_t)row0 * 6144 + (which - 1) * 2048 + col0;
#pragma unroll
        for (int ai = 0; ai < 2; ++ai) {
            u32x4 P[4][2], Q[4][2];
#pragma unroll
            for (int m = 0; m < 4; ++m)
#pragma unroll
                for (int bj = 0; bj < 2; ++bj) { const bf16_t* gp = gbase + (size_t)(ai * HALF + m * 16) * 6144 + bj * HALF; P[m][bj] = *(const u32x4*)gp; Q[m][bj] = *(const u32x4*)(gp + 2048); }
#pragma unroll
            for (int m = 0; m < 4; ++m)
#pragma unroll
                for (int bj = 0; bj < 2; ++bj) { const u32x4 p = P[m][bj], q = Q[m][bj];
                    f32x4 r0, r1;
                    r0[0] = bflo(p.x) * __builtin_amdgcn_rcpf(fmaxf(bflo(q.x), 1e-30f)); r0[1] = bfhi(p.x) * __builtin_amdgcn_rcpf(fmaxf(bfhi(q.x), 1e-30f));
                    r0[2] = bflo(p.y) * __builtin_amdgcn_rcpf(fmaxf(bflo(q.y), 1e-30f)); r0[3] = bfhi(p.y) * __builtin_amdgcn_rcpf(fmaxf(bfhi(q.y), 1e-30f));
                    r1[0] = bflo(p.z) * __builtin_amdgcn_rcpf(fmaxf(bflo(q.z), 1e-30f)); r1[1] = bfhi(p.z) * __builtin_amdgcn_rcpf(fmaxf(bfhi(q.z), 1e-30f));
                    r1[2] = bflo(p.w) * __builtin_amdgcn_rcpf(fmaxf(bflo(q.w), 1e-30f)); r1[3] = bfhi(p.w) * __builtin_amdgcn_rcpf(fmaxf(bfhi(q.w), 1e-30f));
                    acc[ai][bj][m][0] = acc[ai][bj][m][0] * (r0 * sc); acc[ai][bj][m][1] = acc[ai][bj][m][1] * (r1 * sc); }
            asm volatile("" ::: "memory"); }
    }
    __device__ __forceinline__ void operator()(const f32x4 (&acc)[2][2][4][2], const Unit& u, int wr, int wc, int fr, int fq) const {
        const int br = F8B ? 2 : u.aux, row0 = u.pm * BM + wr * 64 + fr, col0 = u.pn * BM + wc * 32 + 8 * fq;
        const float gsc = (F8B ? 1.0f / S_YC : 1.0f) * (GATE8 ? 1.0f / 255.0f : 1.0f);
#pragma unroll
        for (int ai = 0; ai < 2; ++ai)
#pragma unroll
            for (int m = 0; m < 4; ++m) { const int t = row0 + ai * HALF + m * 16;
#pragma unroll
                for (int bj = 0; bj < 2; ++bj) {
                    bf16_t* yp = Y + (size_t)t * 2048 + col0 + bj * HALF;
                    f32x4 v0 = acc[ai][bj][m][0] * gsc, v1 = acc[ai][bj][m][1] * gsc;
                    if constexpr (GATE8) { const u32x2 g8 = *(const u32x2*)((const unsigned char*)GATES + (size_t)t * 6144 + br * 2048 + col0 + bj * HALF);
                        v0[0] *= ub0(g8.x); v0[1] *= ub1(g8.x); v0[2] *= ub2(g8.x); v0[3] *= ub3(g8.x); v1[0] *= ub0(g8.y); v1[1] *= ub1(g8.y); v1[2] *= ub2(g8.y); v1[3] *= ub3(g8.y); }
                    else { const u32x4 gw = *(const u32x4*)(GATES + (size_t)t * 6144 + br * 2048 + col0 + bj * HALF);
                    v0[0] *= bflo(gw.x); v0[1] *= bfhi(gw.x); v0[2] *= bflo(gw.y); v0[3] *= bfhi(gw.y);
                    v1[0] *= bflo(gw.z); v1[1] *= bfhi(gw.z); v1[2] *= bflo(gw.w); v1[3] *= bfhi(gw.w); }
                    if constexpr (F8B) { u32x2 o; o.x = pack4_fp8s(v0[0], v0[1], v0[2], v0[3], S_Y); o.y = pack4_fp8s(v1[0], v1[1], v1[2], v1[3], S_Y); *(u32x2*)(Y8 + (size_t)t * 2048 + col0 + bj * HALF) = o; }
                    else { if (br > 0) { const u32x4 yw = *(const u32x4*)yp;
                            v0[0] += bflo(yw.x); v0[1] += bfhi(yw.x); v0[2] += bflo(yw.y); v0[3] += bfhi(yw.y);
                            v1[0] += bflo(yw.z); v1[1] += bfhi(yw.z); v1[2] += bflo(yw.w); v1[3] += bfhi(yw.w); }
                        *(u32x4*)yp = pack8(v0, v1); } } }
    }
};
struct EpiOut {
    static constexpr bool PERM = false;
    static constexpr bool MIDSCALE = false;
    __device__ __forceinline__ float unit_scale(const Unit&) const { return 1.0f; }
    const bf16_t* X; bf16_t* U; const float* G1;
    __device__ __forceinline__ void operator()(const f32x4 (&acc)[2][2][4][2], const Unit& u, int wr, int wc, int fr, int fq) const {
        const int row0 = u.pm * BM + wr * 64 + fr, col0 = u.pn * BM + wc * 32 + 4 * fq, b = (u.pm * BM) >> 12;
        f32x4 g[2][2], xb[2][2][2];
#pragma unroll
        for (int bj = 0; bj < 2; ++bj)
#pragma unroll
            for (int n = 0; n < 2; ++n) g[bj][n] = *(const f32x4*)(G1 + (size_t)b * 12288 + col0 + bj * HALF + n * 16);
#define EO_LOAD(k) do { const size_t xo_ = (size_t)(row0 + ((k) >> 2) * HALF + ((k) & 3) * 16) * 2048 + col0; \
        _Pragma("unroll") for (int bj = 0; bj < 2; ++bj) _Pragma("unroll") for (int n = 0; n < 2; ++n) xb[(k) % 2][bj][n] = ld_bf4(X + xo_ + bj * HALF + n * 16); asm volatile("" ::: "memory"); } while (0)
        EO_LOAD(0);
#pragma unroll
        for (int k = 0; k < 8; ++k) { const int ai = k >> 2, m = k & 3;
            if (k + 1 < 8) EO_LOAD(k + 1);
            bf16_t* up = U + (size_t)(row0 + ai * HALF + m * 16) * 2048 + col0;
#pragma unroll
            for (int bj = 0; bj < 2; ++bj)
#pragma unroll
                for (int n = 0; n < 2; ++n) *(u32x2*)(up + bj * HALF + n * 16) = pk_bf4(xb[k % 2][bj][n] * ALPHA + g[bj][n] * acc[ai][bj][m][n]);
            asm volatile("" ::: "memory"); }
#undef EO_LOAD
    }
};
struct EpiMoeUp {
    static constexpr bool PERM = true;
    static constexpr bool MIDSCALE = false;
    __device__ __forceinline__ float unit_scale(const Unit&) const { return 1.0f; }
    bf16_t* HID; const LAS float* GW;
    __device__ __forceinline__ void operator()(const f32x4 (&acc)[2][2][4][2], const Unit& u, int wr, int wc, int fr, int fq) const {
        const int row0 = u.pm * BM + wr * 64 + fr, col0 = u.pn * HALF + wc * 32 + 8 * fq;
#pragma unroll
        for (int ai = 0; ai < 2; ++ai)
#pragma unroll
            for (int m = 0; m < 4; ++m) { const int rr = row0 + ai * HALF + m * 16; const float gw = GW[((u.aux >> 8) & 1) * 256 + wr * 64 + fr + ai * HALF + m * 16];
                f32x4 v0, v1;
#pragma unroll
                for (int j = 0; j < 4; ++j) { const float a = acc[ai][0][m][0][j], b = acc[ai][0][m][1][j];
                    v0[j] = a * sigmoidf_(a) * acc[ai][1][m][0][j] * gw; v1[j] = b * sigmoidf_(b) * acc[ai][1][m][1][j] * gw; }
                if constexpr (F8D) { u32x2 o; o.x = pack4_fp8s(v0[0], v0[1], v0[2], v0[3], S_HID); o.y = pack4_fp8s(v1[0], v1[1], v1[2], v1[3], S_HID); *(u32x2*)((unsigned char*)HID + (size_t)rr * EH + col0) = o; }
                else *(u32x4*)(HID + (size_t)rr * EH + col0) = pack8(v0, v1); }
    }
};
struct EpiMoeDown {
    static constexpr bool PERM = true;
    static constexpr bool MIDSCALE = false;
    __device__ __forceinline__ float unit_scale(const Unit&) const { return 1.0f; }
    bf16_t* OS;
    __device__ __forceinline__ void operator()(const f32x4 (&acc)[2][2][4][2], const Unit& u, int wr, int wc, int fr, int fq) const {
        const int row0 = u.pm * BM + wr * 64 + fr, col0 = u.pn * BM + wc * 32 + 8 * fq;
#pragma unroll
        for (int ai = 0; ai < 2; ++ai)
#pragma unroll
            for (int m = 0; m < 4; ++m) { const int rr = row0 + ai * HALF + m * 16;
#pragma unroll
                for (int bj = 0; bj < 2; ++bj) *(u32x4*)(OS + (size_t)rr * 2048 + col0 + bj * HALF) = pack8(acc[ai][bj][m][0], acc[ai][bj][m][1]); }
    }
};
}

namespace att {
typedef int i32x4a __attribute__((ext_vector_type(4)));
typedef int i32x8a __attribute__((ext_vector_type(8)));
constexpr int NW = 8, QBLK = 32, KVBLK = 64;
#define SBAR() __builtin_amdgcn_sched_barrier(0)
__device__ __forceinline__ int crow(int r, int hi) { return (r & 3) + 8 * (r >> 2) + 4 * hi; }
template <int DK> __device__ __forceinline__ int kswz(int row, int colB) { return row * (2 * DK) + (colB ^ (((row >> 1) & 7) << 4)); }
template <int DV> __device__ __forceinline__ int v_st(int k, int c) { const int kk = (k & ~0xC) | ((k & 4) << 1) | ((k & 8) >> 1); return ((kk >> 3) * (DV / 32) + (c >> 5)) * 512 + ((kk & 7) * 32 + (c & 31)) * 2; }
__device__ __forceinline__ int v_rd_base(int lane) { return ((lane & 3) << 3) | (((lane >> 2) & 3) << 6) | (((lane >> 4) & 1) << 5) | (((lane >> 5) & 1) << 8); }
template <int OFF> __device__ __forceinline__ s16x4 tr_read(int vb) { s16x4 r; asm volatile("ds_read_b64_tr_b16 %0, %1 offset:%2" : "=&v"(r) : "v"(vb), "i"(OFF) : "memory"); return r; }

template <bool MASK>
__device__ __forceinline__ void partialSM(f32x16& p0, f32x16& p1, float& m_reg, float& mn, float& alpha, float C, float thr_raw, int kb, int hi, float ebias = 0.f) {
    if (MASK) {
#pragma unroll
        for (int r = 0; r < 16; ++r) { const int d0 = kb + crow(r, hi), d1 = d0 + 32;
            if (d0 < -128 || d0 > 128) p0[r] = -1e30f; if (d1 < -128 || d1 > 128) p1[r] = -1e30f; }
    }
    float pmax = p0[0];
#pragma unroll
    for (int r = 1; r < 16; ++r) pmax = fmaxf(pmax, p0[r]);
#pragma unroll
    for (int r = 0; r < 16; ++r) pmax = fmaxf(pmax, p1[r]);
    { auto rr = __builtin_amdgcn_permlane32_swap(__float_as_uint(pmax), __float_as_uint(pmax), false, false);
      pmax = fmaxf(__uint_as_float(rr[0]), __uint_as_float(rr[1])); }
    if (__builtin_expect(__all(pmax - m_reg <= thr_raw), 1)) { mn = m_reg; alpha = 1.f; }
    else { mn = fmaxf(m_reg, pmax); alpha = __builtin_amdgcn_exp2f((m_reg - mn) * C); m_reg = mn; }
    const float mnC = ebias - mn * C;
#pragma unroll
    for (int r = 0; r < 16; ++r) p0[r] = fmaf(p0[r], C, mnC);
#pragma unroll
    for (int r = 0; r < 16; ++r) p1[r] = fmaf(p1[r], C, mnC);
#pragma unroll
    for (int r = 0; r < 16; ++r) p0[r] = __builtin_amdgcn_exp2f(p0[r]);
}
__device__ __forceinline__ void finishSM(f32x16& p0, f32x16& p1, float alpha, float& l_reg, bf16x8& pa0, bf16x8& pa1, bf16x8& pa2, bf16x8& pa3) {
#pragma unroll
    for (int r = 0; r < 16; ++r) p1[r] = __builtin_amdgcn_exp2f(p1[r]);
    float ps = 0;
#pragma unroll
    for (int r = 0; r < 16; ++r) ps += p0[r];
#pragma unroll
    for (int r = 0; r < 16; ++r) ps += p1[r];
    { auto rr = __builtin_amdgcn_permlane32_swap(__float_as_uint(ps), __float_as_uint(ps), false, false);
      ps = __uint_as_float(rr[0]) + __uint_as_float(rr[1]); }
    l_reg = l_reg * alpha + ps;
#define PK4(P, BASE, OUT) do { unsigned a0 = cvt_pk_bf16(P[BASE + 0], P[BASE + 1]), a1 = cvt_pk_bf16(P[BASE + 2], P[BASE + 3]);   \
    unsigned b0 = cvt_pk_bf16(P[BASE + 4], P[BASE + 5]), b1 = cvt_pk_bf16(P[BASE + 6], P[BASE + 7]);                              \
    auto r0 = __builtin_amdgcn_permlane32_swap(a0, b0, false, false); auto r1 = __builtin_amdgcn_permlane32_swap(a1, b1, false, false); \
    u32x4 w = {r0[0], r1[0], r0[1], r1[1]}; OUT = *reinterpret_cast<bf16x8*>(&w); } while (0)
    PK4(p0, 0, pa0); PK4(p0, 8, pa1); PK4(p1, 0, pa2); PK4(p1, 8, pa3);
#undef PK4
}
__device__ __forceinline__ void finishSM8(f32x16& p0, f32x16& p1, float alpha, float& l_reg, i32x8a& P8) {
#pragma unroll
    for (int r = 0; r < 16; ++r) p1[r] = __builtin_amdgcn_exp2f(p1[r]);
    float ps = 0;
#pragma unroll
    for (int r = 0; r < 16; ++r) ps += p0[r];
#pragma unroll
    for (int r = 0; r < 16; ++r) ps += p1[r];
    { auto rr = __builtin_amdgcn_permlane32_swap(__float_as_uint(ps), __float_as_uint(ps), false, false);
      ps = __uint_as_float(rr[0]) + __uint_as_float(rr[1]); }
    l_reg = l_reg * alpha + ps;
#pragma unroll
    for (int g = 0; g < 4; ++g) { P8[g] = (int)pack4_fp8(p0[4 * g], p0[4 * g + 1], p0[4 * g + 2], p0[4 * g + 3]); P8[4 + g] = (int)pack4_fp8(p1[4 * g], p1[4 * g + 1], p1[4 * g + 2], p1[4 * g + 3]); }
}
__device__ __forceinline__ void finishSM8n(f32x16& p0, f32x16& p1, i32x8a& P8) {
#pragma unroll
    for (int r = 0; r < 16; ++r) p1[r] = __builtin_amdgcn_exp2f(p1[r]);
#pragma unroll
    for (int g = 0; g < 4; ++g) { P8[g] = (int)pack4_fp8(p0[4 * g], p0[4 * g + 1], p0[4 * g + 2], p0[4 * g + 3]); P8[4 + g] = (int)pack4_fp8(p1[4 * g], p1[4 * g + 1], p1[4 * g + 2], p1[4 * g + 3]); }
}
template <int DV> __device__ __forceinline__ void pv_all8(f32x16* o, const char* Vs, int vo0, int vo1, i32x8a P8) {
#pragma unroll
    for (int d = 0; d < DV / 32; ++d) { const i32x4a lo = *reinterpret_cast<const i32x4a*>(Vs + vo0 + d * 2048), hh = *reinterpret_cast<const i32x4a*>(Vs + vo1 + d * 2048);
        const i32x8a Vf = __builtin_shufflevector(lo, hh, 0, 1, 2, 3, 4, 5, 6, 7);
        o[d] = __builtin_amdgcn_mfma_scale_f32_32x32x64_f8f6f4(P8, Vf, o[d], 0, 0, 0, 0, 0, 0); }
}
template <int DK>
__device__ __forceinline__ void qkt(f32x16& p0, f32x16& p1, const char* Ks, const bf16x8* qr, int r32, int hi) {
    p0 = f32x16{}; p1 = f32x16{};
#pragma unroll
    for (int d0 = 0; d0 < DK / 16; ++d0) { const int cb = (d0 * 16 + hi * 8) * 2;
        const bf16x8 b0 = *reinterpret_cast<const bf16x8*>(Ks + kswz<DK>(r32, cb));
        const bf16x8 b1 = *reinterpret_cast<const bf16x8*>(Ks + kswz<DK>(32 + r32, cb));
        p0 = __builtin_amdgcn_mfma_f32_32x32x16_bf16(b0, qr[d0], p0, 0, 0, 0);
        p1 = __builtin_amdgcn_mfma_f32_32x32x16_bf16(b1, qr[d0], p1, 0, 0, 0); }
}
template <int DV, int D0> __device__ __forceinline__ void pv_one(f32x16& od, int vb, bf16x8 pa0, bf16x8 pa1, bf16x8 pa2, bf16x8 pa3) {
    constexpr int KS = (DV / 32) * 1024, HF = (DV / 32) * 512;
    const s16x4 l0 = tr_read<D0 * 512 + 0 * KS>(vb), h0 = tr_read<D0 * 512 + 0 * KS + HF>(vb), l1 = tr_read<D0 * 512 + 1 * KS>(vb), h1 = tr_read<D0 * 512 + 1 * KS + HF>(vb);
    const s16x4 l2 = tr_read<D0 * 512 + 2 * KS>(vb), h2 = tr_read<D0 * 512 + 2 * KS + HF>(vb), l3 = tr_read<D0 * 512 + 3 * KS>(vb), h3 = tr_read<D0 * 512 + 3 * KS + HF>(vb);
    asm volatile("s_waitcnt lgkmcnt(0)" ::: "memory"); SBAR();
#define PK(L, H) (bf16x8){L[0], L[1], L[2], L[3], H[0], H[1], H[2], H[3]}
    od = __builtin_amdgcn_mfma_f32_32x32x16_bf16(pa0, PK(l0, h0), od, 0, 0, 0);
    od = __builtin_amdgcn_mfma_f32_32x32x16_bf16(pa1, PK(l1, h1), od, 0, 0, 0);
    od = __builtin_amdgcn_mfma_f32_32x32x16_bf16(pa2, PK(l2, h2), od, 0, 0, 0);
    od = __builtin_amdgcn_mfma_f32_32x32x16_bf16(pa3, PK(l3, h3), od, 0, 0, 0);
#undef PK
}
template <int DV, int KSI> __device__ __forceinline__ void pv_ks(f32x16* o, int vb, bf16x8 pa) {
    constexpr int KS = (DV / 32) * 1024, HF = (DV / 32) * 512;
    const s16x4 l0 = tr_read<0 * 512 + KSI * KS>(vb), h0 = tr_read<0 * 512 + KSI * KS + HF>(vb), l1 = tr_read<1 * 512 + KSI * KS>(vb), h1 = tr_read<1 * 512 + KSI * KS + HF>(vb);
#define PK(L, H) (bf16x8){L[0], L[1], L[2], L[3], H[0], H[1], H[2], H[3]}
    if constexpr (DV == 128) {
        const s16x4 l2 = tr_read<2 * 512 + KSI * KS>(vb), h2 = tr_read<2 * 512 + KSI * KS + HF>(vb), l3 = tr_read<3 * 512 + KSI * KS>(vb), h3 = tr_read<3 * 512 + KSI * KS + HF>(vb);
        asm volatile("s_waitcnt lgkmcnt(0)" ::: "memory"); SBAR();
        o[0] = __builtin_amdgcn_mfma_f32_32x32x16_bf16(pa, PK(l0, h0), o[0], 0, 0, 0); o[1] = __builtin_amdgcn_mfma_f32_32x32x16_bf16(pa, PK(l1, h1), o[1], 0, 0, 0);
        o[2] = __builtin_amdgcn_mfma_f32_32x32x16_bf16(pa, PK(l2, h2), o[2], 0, 0, 0); o[3] = __builtin_amdgcn_mfma_f32_32x32x16_bf16(pa, PK(l3, h3), o[3], 0, 0, 0);
    } else {
        asm volatile("s_waitcnt lgkmcnt(0)" ::: "memory"); SBAR();
        o[0] = __builtin_amdgcn_mfma_f32_32x32x16_bf16(pa, PK(l0, h0), o[0], 0, 0, 0); o[1] = __builtin_amdgcn_mfma_f32_32x32x16_bf16(pa, PK(l1, h1), o[1], 0, 0, 0);
    }
#undef PK
}
template <int DV> __device__ __forceinline__ void pv_all(f32x16* o, int vb, bf16x8 pa0, bf16x8 pa1, bf16x8 pa2, bf16x8 pa3) {
    pv_ks<DV, 0>(o, vb, pa0); pv_ks<DV, 1>(o, vb, pa1); pv_ks<DV, 2>(o, vb, pa2); pv_ks<DV, 3>(o, vb, pa3);
}

template <int DK, int DV, int SD, bool MASK>
__device__ __forceinline__ void attn_body(const bf16_t* __restrict__ Qw0, int ldq, const bf16_t* __restrict__ Kh, int ldk, const bf16_t* __restrict__ Vh, int ldv, int NT,
                                          float C, float thr_raw, float m_init, float l_init, int qrel, char* lds, f32x16 (&o)[DV / 32], float& l_out, int wv) {
    constexpr int NCK = DK / 8, NCV = DV / 8, PKN = DK / 64, PVN = DV / 64, NDK = DK / 16, NOB = DV / 32;
    constexpr int SHM_K = KVBLK * DK * 2, SHM_V = KVBLK * DV * 2;
    const int tid = opaque_tid(wv), wid = tid >> 6, lane = tid & 63, r32 = lane & 31, hi = lane >> 5;
    char* V_lds = lds; char* K_lds = lds + 2 * SHM_V;
    float* wsf = (float*)(lds + 2 * SHM_V + 2 * SHM_K) + wid * 64; float* al_l = wsf + 32;
    float m_reg = m_init, l_reg = l_init;
#pragma unroll
    for (int d = 0; d < NOB; ++d) o[d] = f32x16{};
    bf16x8 qr[NDK];
    const bf16_t* Qw = Qw0 + (size_t)r32 * ldq + hi * 8;
#pragma unroll
    for (int d0 = 0; d0 < NDK; ++d0) qr[d0] = *reinterpret_cast<const bf16x8*>(Qw + d0 * 16);
    int kg[PKN], kl[PKN], vg[PVN], vl[PVN];
#pragma unroll
    for (int i = 0; i < PKN; ++i) { const int q = tid + 512 * i, row = q / NCK, ch = q % NCK; kg[i] = row * ldk + ch * 8; kl[i] = kswz<DK>(row, ch * 16); }
#pragma unroll
    for (int i = 0; i < PVN; ++i) { const int q = tid + 512 * i, row = q / NCV, ch = q % NCV; vg[i] = row * ldv + ch * 8; vl[i] = v_st<DV>(row, ch * 8); }
    const int vb0 = (int)(uintptr_t)V_lds + v_rd_base(lane);
    const int qpos = qrel + r32;
    bf16x8 ks_[SD][PKN], vs_[SD][PVN];
#define SLOAD(i, k0) do { _Pragma("unroll") for (int _p = 0; _p < PVN; ++_p) vs_[i][_p] = *reinterpret_cast<const bf16x8*>(Vh + (size_t)(k0) * ldv + vg[_p]); \
    _Pragma("unroll") for (int _p = 0; _p < PKN; ++_p) ks_[i][_p] = *reinterpret_cast<const bf16x8*>(Kh + (size_t)(k0) * ldk + kg[_p]); } while (0)
#define SWRITE(b, i) do { _Pragma("unroll") for (int _p = 0; _p < PVN; ++_p) *reinterpret_cast<bf16x8*>(V_lds + (b) * SHM_V + vl[_p]) = vs_[i][_p]; \
    _Pragma("unroll") for (int _p = 0; _p < PKN; ++_p) *reinterpret_cast<bf16x8*>(K_lds + (b) * SHM_K + kl[_p]) = ks_[i][_p]; } while (0)
#define SWAIT() do { if constexpr (SD == 2) asm volatile("s_waitcnt vmcnt(%0)" :: "n"(PKN + PVN) : "memory"); else asm volatile("s_waitcnt vmcnt(0)" ::: "memory"); } while (0)
#define RESC(a) do { if (__any((a) < 1.f)) { if (hi == 0) al_l[r32] = (a); asm volatile("s_waitcnt lgkmcnt(0)" ::: "memory"); \
    _Pragma("unroll") for (int _d = 0; _d < NOB; ++_d) _Pragma("unroll") for (int _r = 0; _r < 16; ++_r) o[_d][_r] *= al_l[crow(_r, hi)]; } } while (0)
    f32x16 pA0, pA1, pB0, pB1; float mnA, mnB, alA, alB; bf16x8 pa0, pa1, pa2, pa3;
    constexpr int SE = 0, SO = SD - 1;
    SLOAD(SE, 0); asm volatile("s_waitcnt vmcnt(0)" ::: "memory"); SWRITE(0, SE); __syncthreads();
    qkt<DK>(pA0, pA1, K_lds, qr, r32, hi); partialSM<MASK>(pA0, pA1, m_reg, mnA, alA, C, thr_raw, 0 - qpos, hi);
    SLOAD(SO, KVBLK); if constexpr (SD == 2) { if (2 < NT) SLOAD(SE, 2 * KVBLK); }
    SWAIT(); SWRITE(1, SO); __syncthreads();
    for (int j = 1; j + 1 < NT; j += 2) {
        SBAR(); qkt<DK>(pB0, pB1, K_lds + SHM_K, qr, r32, hi);
        finishSM(pA0, pA1, alA, l_reg, pa0, pa1, pa2, pa3); SBAR();
        SLOAD(SO, (j + SD) * KVBLK); SBAR();
        pv_all<DV>(o, vb0, pa0, pa1, pa2, pa3); partialSM<MASK>(pB0, pB1, m_reg, mnB, alB, C, thr_raw, j * KVBLK - qpos, hi);
        __syncthreads(); SWAIT(); SWRITE(0, SE);
        RESC(alB); __syncthreads();
        SBAR(); qkt<DK>(pA0, pA1, K_lds, qr, r32, hi);
        finishSM(pB0, pB1, alB, l_reg, pa0, pa1, pa2, pa3); SBAR();
        if (SD == 1 || j + 3 < NT) SLOAD(SE, (j + 1 + SD) * KVBLK); SBAR();
        pv_all<DV>(o, vb0 + SHM_V, pa0, pa1, pa2, pa3); partialSM<MASK>(pA0, pA1, m_reg, mnA, alA, C, thr_raw, (j + 1) * KVBLK - qpos, hi);
        __syncthreads(); SWAIT(); SWRITE(1, SO);
        RESC(alA); __syncthreads();
    }
    SBAR(); qkt<DK>(pB0, pB1, K_lds + SHM_K, qr, r32, hi);
    finishSM(pA0, pA1, alA, l_reg, pa0, pa1, pa2, pa3); SBAR();
    pv_all<DV>(o, vb0, pa0, pa1, pa2, pa3); partialSM<MASK>(pB0, pB1, m_reg, mnB, alB, C, thr_raw, (NT - 1) * KVBLK - qpos, hi);
    __syncthreads(); RESC(alB);
    finishSM(pB0, pB1, alB, l_reg, pa0, pa1, pa2, pa3); SBAR();
    pv_all<DV>(o, vb0 + SHM_V, pa0, pa1, pa2, pa3);
    l_out = l_reg;
#undef SLOAD
#undef SWRITE
#undef SWAIT
#undef RESC
}
template <int DK, int DV, bool MASK, bool PV8 = false, bool QK8 = false>
__device__ __forceinline__ void attn_body_dma(const bf16_t* __restrict__ Qw0, int ldq, const bf16_t* __restrict__ Kh, int ldk, const bf16_t* __restrict__ Vh, int ldv, int NT,
                                              float C, float thr_raw, float m_init, float l_init, int qrel, char* lds, f32x16 (&o)[DV / 32], float& l_out, int wv, f32x16* lrow = nullptr) {
    constexpr int NCK = DK / 8, NC8 = DK / 16, NQ8 = DK / 64, PKN = QK8 ? (KVBLK * NC8 + 511) / 512 : DK / 64, PVN = PV8 ? (DV + 127) / 128 : DV / 64, NDK = DK / 16, NOB = DV / 32;
    constexpr int SHM_K = QK8 ? KVBLK * DK : KVBLK * DK * 2, SHM_V = PV8 ? DV * 64 : KVBLK * DV * 2, SLOT = SHM_K + SHM_V;
    static_assert(!QK8 || (DK % 64 == 0 && PV8), "fp8 Q K^T: head dim a multiple of 64, with the fp8 P V path");
    static_assert(!PV8 || DV <= 128, "fp8 P V: one DMA instruction per V^T tile");
    const float ebias = PV8 ? PV8_LOG2S : 0.f;
    const int tid = opaque_tid(wv), wid = __builtin_amdgcn_readfirstlane(tid >> 6), lane = tid & 63, r32 = lane & 31, hi = lane >> 5;
    float* wsf = (float*)(lds + 3 * SLOT) + wid * 64; float* al_l = wsf + 32;
    float m_reg = m_init, l_reg = l_init;
#pragma unroll
    for (int d = 0; d < NOB; ++d) o[d] = f32x16{};
    bf16x8 qr[QK8 ? 1 : NDK]; i32x8a q8[QK8 ? NQ8 : 1];
    if constexpr (QK8) {
#pragma unroll
        for (int d = 0; d < NQ8; ++d) { const i32x4a* qp = (const i32x4a*)((const unsigned char*)Qw0 + (size_t)r32 * ldq + d * 64 + hi * 32); const i32x4a qa = qp[0], qb = qp[1]; q8[d] = __builtin_shufflevector(qa, qb, 0, 1, 2, 3, 4, 5, 6, 7); } }
    else { const bf16_t* Qw = Qw0 + (size_t)r32 * ldq + hi * 8;
#pragma unroll
        for (int d0 = 0; d0 < NDK; ++d0) qr[d0] = *reinterpret_cast<const bf16x8*>(Qw + d0 * 16); }
    const __amdgpu_buffer_rsrc_t rsK = __builtin_amdgcn_make_buffer_rsrc((void*)Kh, (short)0, 0xFFFFFFFF, 0x00020000);
    const __amdgpu_buffer_rsrc_t rsV = __builtin_amdgcn_make_buffer_rsrc((void*)Vh, (short)0, 0xFFFFFFFF, 0x00020000);
    unsigned voK[PKN], voV[PVN];
#pragma unroll
    for (int n = 0; n < PKN; ++n) { const int q = n * 512 + wid * 64 + lane;
        if constexpr (QK8) { const int row = (q / NC8) & 63, pp = q % NC8; voK[n] = (unsigned)(row * ldk + ((pp ^ ((row >> 2) & 3)) << 4)); }
        else { const int row = q / NCK, ch = q % NCK; voK[n] = (unsigned)(row * ldk * 2 + ((ch ^ ((row >> 1) & 7)) << 4)); } }
#pragma unroll
    for (int n = 0; n < PVN; ++n) { const int q = n * 512 + wid * 64 + lane;
        if constexpr (PV8) { const int row = q >> 2, pp = q & 3; voV[n] = (unsigned)(row * ldv + ((pp ^ ((row >> 2) & 3)) << 4)); }
        else { const int sub = q >> 5, key8 = (q & 31) >> 2, cc = q & 3, kk = (sub / (DV / 32)) * 8 + key8, col = (sub % (DV / 32)) * 32 + cc * 8;
            const int k = (kk & ~0xC) | ((kk & 4) << 1) | ((kk & 8) >> 1); voV[n] = (unsigned)(k * ldv * 2 + col * 2); } }
    LAS unsigned char* ldsl = (LAS unsigned char*)(uintptr_t)(unsigned)(uintptr_t)lds;
    const unsigned tstepK = QK8 ? (unsigned)(KVBLK * ldk) : (unsigned)(KVBLK * ldk * 2), tstepV = PV8 ? (unsigned)KVBLK : (unsigned)(KVBLK * ldv * 2);
#define ADMA(tile, slot) do { { _Pragma("unroll") for (int _n = 0; _n < PKN; ++_n) if (!QK8 || _n * 512 + wid * 64 < KVBLK * NC8) __builtin_amdgcn_raw_ptr_buffer_load_lds(rsK, (LAS unsigned*)(ldsl + (slot) * SLOT + _n * 8192 + wid * 1024), 16, voK[_n], (unsigned)(tile) * tstepK, 0, 0); } \
    _Pragma("unroll") for (int _n = 0; _n < PVN; ++_n) if (!PV8 || wid * 64 < DV * 4) __builtin_amdgcn_raw_ptr_buffer_load_lds(rsV, (LAS unsigned*)(ldsl + (slot) * SLOT + SHM_K + _n * 8192 + wid * 1024), 16, voV[_n], (unsigned)(tile) * tstepV, 0, 0); } while (0)
#define ARESC(a) do { if (__any((a) < 1.f)) { if (hi == 0) al_l[r32] = (a); asm volatile("s_waitcnt lgkmcnt(0)" ::: "memory"); \
    _Pragma("unroll") for (int _d = 0; _d < NOB; ++_d) _Pragma("unroll") for (int _r = 0; _r < 16; ++_r) o[_d][_r] *= al_l[crow(_r, hi)]; \
    if constexpr (PV8) { _Pragma("unroll") for (int _r = 0; _r < 16; ++_r) lacc[_r] *= al_l[crow(_r, hi)]; } } } while (0)
#define ALAND() do { asm volatile("s_waitcnt vmcnt(0)" ::: "memory"); __syncthreads(); } while (0)
    const int vbase = (int)(uintptr_t)lds + SHM_K + v_rd_base(lane);
    const int qpos = qrel + r32;
    f32x16 pA0, pA1, pB0, pB1; float mnA, mnB, alA, alB; bf16x8 pa0, pa1, pa2, pa3; i32x8a P8;
    f32x16 lacc;
#pragma unroll
    for (int r = 0; r < 16; ++r) lacc[r] = PV8 ? l_init * PV8_SCALE : 0.f;
    static_assert(true, "");
    i32x8a ones8; { int one_ = 0x38383838; asm volatile("" : "+v"(one_));
#pragma unroll
        for (int r = 0; r < 8; ++r) ones8[r] = one_; }
    const int k8o0 = r32 * DK + (((2 * hi) ^ ((r32 >> 2) & 3)) << 4), k8o1 = r32 * DK + (((2 * hi + 1) ^ ((r32 >> 2) & 3)) << 4);
    const int v8sw = (r32 >> 2) & 3, v8o0 = SHM_K + r32 * 64 + (((2 * hi) ^ v8sw) << 4), v8o1 = SHM_K + r32 * 64 + (((2 * hi + 1) ^ v8sw) << 4);
#define AQK(P0, P1, S_) do { if constexpr (QK8) { const char* kb_ = lds + (S_) * SLOT; P0 = f32x16{}; P1 = f32x16{}; \
        _Pragma("unroll") for (int d_ = 0; d_ < NQ8; ++d_) { \
        const i32x8a k0_ = __builtin_shufflevector(*reinterpret_cast<const i32x4a*>(kb_ + k8o0 + d_ * 64), *reinterpret_cast<const i32x4a*>(kb_ + k8o1 + d_ * 64), 0, 1, 2, 3, 4, 5, 6, 7); \
        const i32x8a k1_ = __builtin_shufflevector(*reinterpret_cast<const i32x4a*>(kb_ + k8o0 + d_ * 64 + 32 * DK), *reinterpret_cast<const i32x4a*>(kb_ + k8o1 + d_ * 64 + 32 * DK), 0, 1, 2, 3, 4, 5, 6, 7); \
        P0 = __builtin_amdgcn_mfma_scale_f32_32x32x64_f8f6f4(k0_, q8[d_], P0, 0, 0, 0, 0, 0, 0); P1 = __builtin_amdgcn_mfma_scale_f32_32x32x64_f8f6f4(k1_, q8[d_], P1, 0, 0, 0, 0, 0, 0); } } \
        else qkt<DK>(P0, P1, lds + (S_) * SLOT, qr, r32, hi); } while (0)
#define AFIN(P0, P1, AL) do { if constexpr (PV8) finishSM8n(P0, P1, P8); else finishSM(P0, P1, AL, l_reg, pa0, pa1, pa2, pa3); } while (0)
#define APV(S_) do { if constexpr (PV8) { pv_all8<DV>(o, lds + (S_) * SLOT, v8o0, v8o1, P8); lacc = __builtin_amdgcn_mfma_scale_f32_32x32x64_f8f6f4(P8, ones8, lacc, 0, 0, 0, 0, 0, 0); } else pv_all<DV>(o, vbase + (S_) * SLOT, pa0, pa1, pa2, pa3); } while (0)
    __syncthreads();
    ADMA(0, 0); ADMA(1, 1); ALAND();
    AQK(pA0, pA1, 0); partialSM<MASK>(pA0, pA1, m_reg, mnA, alA, C, thr_raw, 0 - qpos, hi, ebias);
    int sj = 1, sp = 0, sn = 2;
    for (int j = 1; j + 1 < NT; j += 2) {
        ADMA(j + 1, sn);
        SBAR(); AQK(pB0, pB1, sj);
        AFIN(pA0, pA1, alA); SBAR();
        APV(sp); partialSM<MASK>(pB0, pB1, m_reg, mnB, alB, C, thr_raw, j * KVBLK - qpos, hi, ebias);
        ARESC(alB); ALAND();
        sp = sj; sj = sn; sn = (sn == 2) ? 0 : sn + 1;
        if (j + 2 < NT) ADMA(j + 2, sn);
        SBAR(); AQK(pA0, pA1, sj);
        AFIN(pB0, pB1, alB); SBAR();
        APV(sp); partialSM<MASK>(pA0, pA1, m_reg, mnA, alA, C, thr_raw, (j + 1) * KVBLK - qpos, hi, ebias);
        ARESC(alA); ALAND();
        sp = sj; sj = sn; sn = (sn == 2) ? 0 : sn + 1;
    }
    SBAR(); AQK(pB0, pB1, sj);
    AFIN(pA0, pA1, alA); SBAR();
    APV(sp); partialSM<MASK>(pB0, pB1, m_reg, mnB, alB, C, thr_raw, (NT - 1) * KVBLK - qpos, hi, ebias);
    ARESC(alB);
    AFIN(pB0, pB1, alB); SBAR();
    APV(sj);
    l_out = l_reg;
    if constexpr (PV8) { if (lrow) *lrow = lacc; }
#undef ADMA
#undef ARESC
#undef ALAND
#undef AFIN
#undef AQK
#undef APV
}
template <int DK, int DV, bool MASK>
__device__ __forceinline__ void attn_body_simple(const bf16_t* __restrict__ Qw0, int ldq, const bf16_t* __restrict__ Kh, int ldk, const bf16_t* __restrict__ Vh, int ldv, int NT,
                                                 float C, float thr_raw, float m_init, float l_init, int qrel, char* lds, f32x16 (&o)[DV / 32], float& l_out, int wv) {
    constexpr int NCK = DK / 8, NCV = DV / 8, PKN = DK / 64, PVN = DV / 64, NDK = DK / 16, NOB = DV / 32;
    constexpr int SHM_K = KVBLK * DK * 2, SHM_V = KVBLK * DV * 2;
    const int tid = opaque_tid(wv), wid = tid >> 6, lane = tid & 63, r32 = lane & 31, hi = lane >> 5;
    char* V_lds = lds; char* K_lds = lds + 2 * SHM_V;
    float* wsf = (float*)(lds + 2 * SHM_V + 2 * SHM_K) + wid * 64; float* al_l = wsf + 32;
    float m_reg = m_init, l_reg = l_init;
#pragma unroll
    for (int d = 0; d < NOB; ++d) o[d] = f32x16{};
    bf16x8 qr[NDK];
    const bf16_t* Qw = Qw0 + (size_t)r32 * ldq + hi * 8;
#pragma unroll
    for (int d0 = 0; d0 < NDK; ++d0) qr[d0] = *reinterpret_cast<const bf16x8*>(Qw + d0 * 16);
    int kg[PKN], kl[PKN], vg[PVN], vl[PVN];
#pragma unroll
    for (int i = 0; i < PKN; ++i) { const int q = tid + 512 * i, row = q / NCK, ch = q % NCK; kg[i] = row * ldk + ch * 8; kl[i] = kswz<DK>(row, ch * 16); }
#pragma unroll
    for (int i = 0; i < PVN; ++i) { const int q = tid + 512 * i, row = q / NCV, ch = q % NCV; vg[i] = row * ldv + ch * 8; vl[i] = v_st<DV>(row, ch * 8); }
    const int vb0 = (int)(uintptr_t)V_lds + v_rd_base(lane);
    const int qpos = qrel + r32;
    bf16x8 ks_[PKN], vs_[PVN];
#define SLOAD1(k0) do { _Pragma("unroll") for (int _p = 0; _p < PVN; ++_p) vs_[_p] = *reinterpret_cast<const bf16x8*>(Vh + (size_t)(k0) * ldv + vg[_p]); \
    _Pragma("unroll") for (int _p = 0; _p < PKN; ++_p) ks_[_p] = *reinterpret_cast<const bf16x8*>(Kh + (size_t)(k0) * ldk + kg[_p]); } while (0)
#define SWRITE1(b) do { _Pragma("unroll") for (int _p = 0; _p < PVN; ++_p) *reinterpret_cast<bf16x8*>(V_lds + (b) * SHM_V + vl[_p]) = vs_[_p]; \
    _Pragma("unroll") for (int _p = 0; _p < PKN; ++_p) *reinterpret_cast<bf16x8*>(K_lds + (b) * SHM_K + kl[_p]) = ks_[_p]; } while (0)
    SLOAD1(0); asm volatile("s_waitcnt vmcnt(0)" ::: "memory"); SWRITE1(0); __syncthreads();
    for (int j = 0; j < NT; ++j) {
        const int bsel = j & 1;
        if (j + 1 < NT) SLOAD1((j + 1) * KVBLK);
        SBAR();
        f32x16 p0, p1; float mn, al; bf16x8 pa0, pa1, pa2, pa3;
        qkt<DK>(p0, p1, K_lds + bsel * SHM_K, qr, r32, hi);
        partialSM<MASK>(p0, p1, m_reg, mn, al, C, thr_raw, j * KVBLK - qpos, hi);
        if (__any(al < 1.f)) { if (hi == 0) al_l[r32] = al; asm volatile("s_waitcnt lgkmcnt(0)" ::: "memory");
#pragma unroll
            for (int d = 0; d < NOB; ++d)
#pragma unroll
                for (int r = 0; r < 16; ++r) o[d][r] *= al_l[crow(r, hi)]; }
        finishSM(p0, p1, al, l_reg, pa0, pa1, pa2, pa3); SBAR();
        pv_all<DV>(o, vb0 + bsel * SHM_V, pa0, pa1, pa2, pa3);
        if (j + 1 < NT) { asm volatile("s_waitcnt vmcnt(0)" ::: "memory"); SWRITE1(bsel ^ 1); }
        __syncthreads();
    }
    l_out = l_reg;
#undef SLOAD1
#undef SWRITE1
}
__device__ __forceinline__ void row_rcp(float l_reg, char* lds, int SHM_KV, float (&rli)[16], int wv) {
    const int tid = opaque_tid(wv), wid = tid >> 6, lane = tid & 63, r32 = lane & 31, hi = lane >> 5;
    float* li_l = (float*)(lds + SHM_KV) + wid * 64;
    if (hi == 0) li_l[r32] = l_reg;
    asm volatile("s_waitcnt lgkmcnt(0)" ::: "memory");
#pragma unroll
    for (int r = 0; r < 16; ++r) rli[r] = __builtin_amdgcn_rcpf(li_l[crow(r, hi)]);
    asm volatile("s_waitcnt lgkmcnt(0)" ::: "memory");
}
}

struct Args { const void* in[27]; float* out; unsigned char* ws; int ph_lo, ph_hi; };

typedef const __attribute__((address_space(4))) Args* KArgs;
__device__ __forceinline__ KArgs get_ka() { KArgs k = (KArgs)__builtin_amdgcn_kernarg_segment_ptr(); asm volatile("" : "+s"(k)); return k; }

struct Ctx {
    LAS unsigned char* lds; char* ldsg; int tid, lane, wave, G, gw, NGW;
    unsigned char* ws;
};

template <bool F8>
__device__ __forceinline__ void transpose_load(f32x4 (&v)[16], const float* W, int ldn, int csA, int csB, int k0, int lane) {
    const int rg = lane >> 4, c16 = lane & 15, cs = (c16 < 8) ? csA : csB;
    if (cs >= 0) {
#pragma unroll
        for (int i = 0; i < 16; ++i) v[i] = __builtin_nontemporal_load((const f32x4*)(W + (size_t)(k0 + 4 * i + rg) * ldn + cs + (c16 & 7) * 4));
    } else {
#pragma unroll
        for (int i = 0; i < 16; ++i) v[i] = (f32x4){0.f, 0.f, 0.f, 0.f};
    }
}
template <bool F8>
__device__ __forceinline__ void transpose_store(f32x4 (&v)[16], int k0, bf16_t* WT, int K, int nrow0, const float* kscale, LAS float* scr, int lane, int kdst) {
    const int rg = lane >> 4, c16 = lane & 15;
#pragma unroll
    for (int i = 0; i < 16; ++i) { const int kk = 4 * i + rg; if (kscale) v[i] = v[i] * kscale[k0 + kk];
        LAS float* p = scr + kk * 65 + c16 * 4; p[0] = v[i][0]; p[1] = v[i][1]; p[2] = v[i][2]; p[3] = v[i][3]; }
    LDS_WAIT(); asm volatile("" ::: "memory");
    const int c = lane & 7;
#pragma unroll
    for (int j = 0; j < 8; ++j) { const int n = (lane >> 3) + 8 * j; const LAS float* q = scr + (8 * c) * 65 + n;
        if constexpr (F8) { u32x2 o; o.x = pack4_fp8(q[0 * 65] * 64.f, q[1 * 65] * 64.f, q[2 * 65] * 64.f, q[3 * 65] * 64.f); o.y = pack4_fp8(q[4 * 65] * 64.f, q[5 * 65] * 64.f, q[6 * 65] * 64.f, q[7 * 65] * 64.f);
            *(u32x2*)((unsigned char*)WT + (size_t)(nrow0 + n) * K + kdst + k0 + 8 * c) = o; }
        else { u32x4 o; o.x = cvt_pk_bf16(q[0 * 65], q[1 * 65]); o.y = cvt_pk_bf16(q[2 * 65], q[3 * 65]); o.z = cvt_pk_bf16(q[4 * 65], q[5 * 65]); o.w = cvt_pk_bf16(q[6 * 65], q[7 * 65]);
            *(u32x4*)(WT + (size_t)(nrow0 + n) * K + k0 + 8 * c) = o; } }
    LDS_WAIT(); asm volatile("" ::: "memory");
}
template <bool F8>
__device__ __forceinline__ void cvt_item(const float* W, int ldn, int csA, int csB, int kb, bf16_t* WT, int K, int nrow0, const float* kscale, LAS float* scr, int lane, int kdst = 0) {
    if constexpr (F8) { f32x4 va[16], vb[16];
        transpose_load<true>(va, W, ldn, csA, csB, kb * 128, lane); transpose_load<true>(vb, W, ldn, csA, csB, kb * 128 + 64, lane);
        transpose_store<true>(va, kb * 128, WT, K, nrow0, kscale, scr, lane, kdst); transpose_store<true>(vb, kb * 128 + 64, WT, K, nrow0, kscale, scr, lane, kdst); }
    else { f32x4 va[16]; transpose_load<false>(va, W, ldn, csA, csB, kb * 64, lane); transpose_store<false>(va, kb * 64, WT, K, nrow0, kscale, scr, lane, 0); }
}
template <bool F8>
__device__ __forceinline__ void transpose_item(const float* W, int ldn, int csrc, int k0, bf16_t* WT, int K, int nrow0, const float* kscale, LAS float* scr, int lane) {
    if (csrc >= 0) {
        f32x4 v[8];
#pragma unroll
        for (int i = 0; i < 8; ++i) v[i] = *(const f32x4*)(W + (size_t)(k0 + 8 * i + (lane >> 3)) * ldn + csrc + (lane & 7) * 4);
#pragma unroll
        for (int i = 0; i < 8; ++i) { const int kk = 8 * i + (lane >> 3); if (kscale) v[i] = v[i] * kscale[k0 + kk];
            LAS float* d = scr + kk * 33 + (lane & 7) * 4; d[0] = v[i][0]; d[1] = v[i][1]; d[2] = v[i][2]; d[3] = v[i][3]; }
    } else {
#pragma unroll 8
        for (int i = 0; i < 32; ++i) { const int kk = 2 * i + (lane >> 5); scr[kk * 33 + (lane & 31)] = 0.f; }
    }
    LDS_WAIT(); asm volatile("" ::: "memory");
    const int c = lane & 7;
#pragma unroll
    for (int j = 0; j < 4; ++j) { const int n = (lane >> 3) + 8 * j; const LAS float* s = scr + (8 * c) * 33 + n;
        if constexpr (F8) {
            u32x2 o; o.x = pack4_fp8(s[0 * 33] * 64.f, s[1 * 33] * 64.f, s[2 * 33] * 64.f, s[3 * 33] * 64.f); o.y = pack4_fp8(s[4 * 33] * 64.f, s[5 * 33] * 64.f, s[6 * 33] * 64.f, s[7 * 33] * 64.f);
            *(u32x2*)((unsigned char*)WT + (size_t)(nrow0 + n) * K + k0 + 8 * c) = o;
        } else {
        u32x4 o; o.x = cvt_pk_bf16(s[0 * 33], s[1 * 33]); o.y = cvt_pk_bf16(s[2 * 33], s[3 * 33]); o.z = cvt_pk_bf16(s[4 * 33], s[5 * 33]); o.w = cvt_pk_bf16(s[6 * 33], s[7 * 33]);
        *(u32x4*)(WT + (size_t)(nrow0 + n) * K + k0 + 8 * c) = o; } }
    LDS_WAIT(); asm volatile("" ::: "memory");
}
__device__ __forceinline__ int win_src(int nb) {
    const int pn = nb >> 3, sub = nb & 7, bj = sub >> 2, hd = sub & 3, rp = 64 * hd + 32 * bj;
    if (pn < 4) return OFF_AQ + pn * 256 + rp;
    if (pn < 8) return OFF_AK + (pn - 4) * 256 + rp;
    if (pn < 12) return OFF_AV + (pn - 8) * 256 + sub * 32;
    if (pn < 14) return OFF_CQ + (pn - 12) * 256 + sub * 32;
    if (pn < 15) return OFF_CKV + sub * 32;
    if (pn < 19) return OFF_SWQ + (pn - 15) * 256 + rp;
    if (pn < 20) return OFF_SWK + rp;
    if (pn < 21) return OFF_SWV + sub * 32;
    if (pn < 45) return OFF_GATE + (pn - 21) * 256 + sub * 32;
    return hd == 0 ? OFF_KR + 32 * bj : -1;
}
__device__ __forceinline__ int wuq_src(int nb) {
    const int pn = nb >> 3, sub = nb & 7;
    if (pn < 4) return (2 * pn + (sub >> 2)) * 192 + 32 * (sub & 3);
    return (4 * (pn - 4) + (sub & 3)) * 192 + 128 + 32 * (sub >> 2);
}
__device__ __forceinline__ int wukv_src(int nb) {
    const int pn = nb >> 3, sub = nb & 7;
    if (pn < 4) return (2 * pn + (sub >> 2)) * 256 + 32 * (sub & 3);
    return (2 * (pn - 4) + (sub >> 2)) * 256 + 128 + 32 * (sub & 3);
}

constexpr int I_WIN = (F8P ? 16 : 32) * 184, I_WUQ = (F8U ? 4 : 8) * 24, I_WUKV = (F8U ? 2 : 4) * 32, I_WABC = 3 * (F8B ? 8 : 16) * 32, I_WO = (F8B ? 16 : 32) * 32, I_W13 = 16 * (F8M ? 16 : 32) * 16, I_W2 = 16 * (F8D ? 4 : 8) * 32;
constexpr int I_LAYER = I_WIN + I_WUQ + I_WUKV + I_WABC + I_WO + I_W13 + I_W2;
__device__ __forceinline__ void convert_item(const Ctx& X, KArgs a, int it, LAS float* scr) {
            const int l = it / I_LAYER; int r = it % I_LAYER;
            unsigned char* wb = X.ws + WS_W + (size_t)l * W_STRIDE;
            if (r < I_WIN) { const int nb = r % 184, kb = r / 184;
                cvt_item<F8P>((const float*)a->in[3] + (size_t)l * DM * IN_WIDTH, IN_WIDTH, win_src(2 * nb), win_src(2 * nb + 1), kb, (bf16_t*)(wb + WO_WIN), DM, nb * 64, nullptr, scr, X.lane); return; }
            r -= I_WIN;
            if (r < I_WUQ) { const int nb = r % 24, kb = r / 24;
                cvt_item<F8U>((const float*)a->in[9] + (size_t)l * 512 * 1536, 1536, wuq_src(2 * nb), wuq_src(2 * nb + 1), kb, (bf16_t*)(wb + WO_WUQ), 512, nb * 64, (const float*)a->in[7] + l * 512, scr, X.lane); return; }
            r -= I_WUQ;
            if (r < I_WUKV) { const int nb = r % 32, kb = r / 32;
                cvt_item<F8U>((const float*)a->in[10] + (size_t)l * 256 * 2048, 2048, wukv_src(2 * nb), wukv_src(2 * nb + 1), kb, (bf16_t*)(wb + WO_WUKV), 256, nb * 64, (const float*)a->in[8] + l * 256, scr, X.lane); return; }
            r -= I_WUKV;
            if (r < I_WABC) { constexpr int NKB = F8B ? 8 : 16; const int br = r / (NKB * 32), q = r % (NKB * 32), nb = q % 32, kb = q / 32;
                if constexpr (F8B) cvt_item<true>((const float*)a->in[12 + br] + (size_t)l * 1024 * 2048, 2048, nb * 64, nb * 64 + 32, kb, (bf16_t*)(wb + WO_WABC), 3072, nb * 64, nullptr, scr, X.lane, br * 1024);
                else cvt_item<false>((const float*)a->in[12 + br] + (size_t)l * 1024 * 2048, 2048, nb * 64, nb * 64 + 32, kb, (bf16_t*)(wb + WO_WABC) + (size_t)br * 2048 * 1024, 1024, nb * 64, nullptr, scr, X.lane);
                return; }
            r -= I_WABC;
            if (r < I_WO) { const int nb = r % 32, kb = r / 32;
                cvt_item<F8B>((const float*)a->in[15] + (size_t)l * 2048 * 2048, 2048, nb * 64, nb * 64 + 32, kb, (bf16_t*)(wb + WO_WO), 2048, nb * 64, nullptr, scr, X.lane); return; }
            r -= I_WO;
            if (r < I_W13) { constexpr int NKB = F8M ? 16 : 32; const int e = r / (NKB * 16), q = r % (NKB * 16), nb = q % 16, kb = q / 16;
                const int g0 = 2 * nb, pn = g0 >> 3, bj = (g0 & 7) >> 2, col = 128 * pn + 32 * (g0 & 3);
                const float* src = (const float*)a->in[bj ? 25 : 24] + ((size_t)l * NEXP + e) * DM * EH;
                bf16_t* dst = F8M ? (bf16_t*)((unsigned char*)(wb + WO_W13) + (size_t)e * 1024 * DM) : (bf16_t*)(wb + WO_W13) + (size_t)e * 1024 * DM;
                cvt_item<F8M>(src, EH, col, col + 32, kb, dst, DM, nb * 64, nullptr, scr, X.lane); return; }
            r -= I_W13;
            { constexpr int NKB = F8D ? 4 : 8; const int e = r / (NKB * 32), q = r % (NKB * 32), nb = q % 32, kb = q / 32;
                bf16_t* dst = F8D ? (bf16_t*)((unsigned char*)(wb + WO_W2) + (size_t)e * DM * EH) : (bf16_t*)(wb + WO_W2) + (size_t)e * DM * EH;
                cvt_item<F8D>((const float*)a->in[26] + ((size_t)l * NEXP + e) * EH * DM, DM, nb * 64, nb * 64 + 32, kb, dst, EH, nb * 64, nullptr, scr, X.lane); }
}
constexpr int D0_ABC0 = I_WIN + I_WUQ + I_WUKV, D0_ABC1 = D0_ABC0 + I_WABC, D0_WOA = D0_ABC1 + 320;
constexpr int D_WIN0 = I_LAYER, D_WIN1 = D_WIN0 + I_WIN, D_UQ1 = D_WIN1 + I_WUQ + I_WUKV, D_ABC1 = D_UQ1 + I_WABC, D_WO1 = D_ABC1 + I_WO, D_W20 = D_WO1 + I_W13, D_W21 = D_W20 + I_W2;
constexpr int D_W13A = D_WO1 + 320, D_W13B = D_WO1 + 560;
__device__ __forceinline__ bool item_deferred(int it) { return (it >= D0_ABC0 && it < D0_WOA) || (it >= D_WIN0 && it < D_W13B) || (it >= D_W20 && it < D_W21); }
__device__ __forceinline__ void convert_range(const Ctx& X, KArgs a, int it0, int it1, int gwi, int niw) {
    __syncthreads();
    LAS float* scr = (LAS float*)(X.lds + X.wave * 16640);
    for (int it = it0 + gwi; it < it1; it += niw) convert_item(X, a, it, scr);
}
__device__ __forceinline__ void phase_prologue(const Ctx& X, KArgs a) {
    const float* c_in = (const float*)a->in[1]; const int* pos = (const int*)a->in[2];
    const float* w_ada = (const float*)a->in[16]; const float* b_ada = (const float*)a->in[17];
    float* MOD = (float*)(X.ws + WS_MOD); float* COS = (float*)(X.ws + WS_COS); float* SIN = (float*)(X.ws + WS_SIN);
    {
        LAS float* cact = (LAS float*)(X.lds + 73728);
        LAS float* part = (LAS float*)(X.lds + 73728 + 16384);
        for (int i = X.tid; i < 2 * DM; i += 512) { const float v = c_in[i]; cact[i] = v * sigmoidf_(v); }
        __syncthreads();
        for (int it = blockIdx.x; it < 2 * 128; it += X.G) {
            const int l = it >> 7, cg = it & 127, kgp = X.tid / 24, l24 = X.tid % 24;
            if (X.tid < 504) {
                const float* wp = w_ada + (size_t)l * DM * 12288 + cg * 96 + l24 * 4;
                f32x4 a0 = {0.f, 0.f, 0.f, 0.f}, a1 = {0.f, 0.f, 0.f, 0.f};
#pragma unroll 14
                for (int k = kgp; k < DM; k += 21) { const f32x4 w = __builtin_nontemporal_load((const f32x4*)(wp + (size_t)k * 12288)); a0 += w * cact[k]; a1 += w * cact[DM + k]; }
                *(LAS f32x4*)(part + (kgp * 2 + 0) * 96 + l24 * 4) = a0; *(LAS f32x4*)(part + (kgp * 2 + 1) * 96 + l24 * 4) = a1; }
            __syncthreads();
            if (X.tid < 192) { const int b = X.tid / 96, cc = X.tid % 96; float s = 0.f;
#pragma unroll
                for (int g = 0; g < 21; ++g) s += part[(g * 2 + b) * 96 + cc];
                MOD[(size_t)(l * 2 + b) * 12288 + cg * 96 + cc] = s + b_ada[l * 12288 + cg * 96 + cc]; }
            __syncthreads();
        }
    }
    for (int i = blockIdx.x * 512 + X.tid; i < T * 32; i += X.G * 512) {
        const int t = i >> 5, f = i & 31; const float p = (float)pos[t];
        const double invd = exp2(-(double)f * (13.287712379549449 / 32.0)) * 0.15915494309189535;
        const float ih = (float)invd, il = (float)(invd - (double)ih);
        const float ph = p * ih, pe = fmaf(p, ih, -ph);
        float fr = (ph - rintf(ph)) + (pe + p * il);
        fr = fr - rintf(fr);
        COS[i] = __builtin_amdgcn_cosf(fr); SIN[i] = __builtin_amdgcn_sinf(fr);
    }
    {
        LAS float* scr = (LAS float*)(X.lds + X.wave * 16640);
        for (int it = X.gw; it < DEPTH * I_LAYER; it += X.NGW) if (!item_deferred(it)) convert_item(X, a, it, scr);
    }
}

__device__ __forceinline__ void row_stats(const f32x4 (&v)[8], float& mean, float& rstd) {
    float s = 0.f;
#pragma unroll
    for (int j = 0; j < 8; ++j) s += (v[j][0] + v[j][1]) + (v[j][2] + v[j][3]);
    mean = wave_sum(s) * (1.0f / DM); float q = 0.f;
#pragma unroll
    for (int j = 0; j < 8; ++j) { const f32x4 d = v[j] - mean; q += (d[0] * d[0] + d[1] * d[1]) + (d[2] * d[2] + d[3] * d[3]); }
    rstd = 1.0f / sqrtf(wave_sum(q) * (1.0f / DM) + LN_EPS);
}
__device__ __forceinline__ void modulate_store(f32x4 (&v)[8], const float* sh, const float* sc, unsigned char* hrow, int lane) {
    float mean, rstd; row_stats(v, mean, rstd);
#pragma unroll
    for (int j = 0; j < 8; ++j) { const int c = 256 * j + 4 * lane; const f32x4 a = *(const f32x4*)(sc + c), b = *(const f32x4*)(sh + c);
        v[j] = (v[j] - mean) * rstd * (a + 1.0f) + b;
        if constexpr (F8P) *(unsigned*)(hrow + c) = pack4_fp8(v[j][0], v[j][1], v[j][2], v[j][3]);
        else { u32x2 w; w.x = cvt_pk_bf16(v[j][0], v[j][1]); w.y = cvt_pk_bf16(v[j][2], v[j][3]); *(u32x2*)(hrow + 2 * c) = w; } }
}
__device__ __forceinline__ void phase_ln1(const Ctx& X, const float* xin, int l) {
    const float* MOD = (const float*)(X.ws + WS_MOD); unsigned char* H = X.ws + WS_H;
    int gw_ = X.gw; asm volatile("" : "+s"(gw_));
    f32x4 vn[8];
#pragma unroll
    for (int j = 0; j < 8; ++j) vn[j] = __builtin_nontemporal_load((const f32x4*)(xin + (size_t)gw_ * DM + 256 * j + 4 * X.lane));
    f32x4 v[8];
#pragma unroll
    for (int j = 0; j < 8; ++j) v[j] = vn[j];
    for (int t = gw_; t < T; t += X.NGW) { const int b = t >> 12; f32x4 pg[8], pb[8];
        const float* mb = MOD + (size_t)(l * 2 + b) * 12288;
#pragma unroll
        for (int j = 0; j < 8; ++j) { const int c = 256 * j + 4 * X.lane; pg[j] = *(const f32x4*)(mb + 1 * DM + c); pb[j] = *(const f32x4*)(mb + 0 * DM + c); }
        asm volatile("" ::: "memory");
        if (t + X.NGW < T) {
#pragma unroll
            for (int j = 0; j < 8; ++j) vn[j] = __builtin_nontemporal_load((const f32x4*)(xin + (size_t)(t + X.NGW) * DM + 256 * j + 4 * X.lane)); }
        asm volatile("" ::: "memory");
        { bf16_t* xc = (bf16_t*)(X.ws + WS_XCUR) + (size_t)t * DM;
#pragma unroll
          for (int j = 0; j < 8; ++j) __builtin_nontemporal_store(pk_bf4(v[j]), (u32x2*)(xc + 256 * j + 4 * X.lane)); }
        float mean, rstd; row_stats(v, mean, rstd); unsigned char* hrow = H + (size_t)t * HROWB;
#pragma unroll
        for (int j = 0; j < 8; ++j) { const int c = 256 * j + 4 * X.lane;
            v[j] = (v[j] - mean) * rstd * (pg[j] + 1.0f) + pb[j];
            if constexpr (F8P) *(unsigned*)(hrow + c) = pack4_fp8(v[j][0], v[j][1], v[j][2], v[j][3]);
            else { u32x2 w; w.x = cvt_pk_bf16(v[j][0], v[j][1]); w.y = cvt_pk_bf16(v[j][2], v[j][3]); *(u32x2*)(hrow + 2 * c) = w; } }
        asm volatile("" ::: "memory");
        if (t + X.NGW < T) {
#pragma unroll
            for (int j = 0; j < 8; ++j) v[j] = vn[j]; } }
}
__device__ __forceinline__ void phase_ln2_route(const Ctx& X, KArgs a, int l) {
    const float* MOD = (const float*)(X.ws + WS_MOD); unsigned char* H = X.ws + WS_H; const bf16_t* U = (const bf16_t*)(X.ws + WS_U); bf16_t* XC = (bf16_t*)(X.ws + WS_XCUR);
    const float* lg = (const float*)a->in[18] + l * DM; const float* lb = (const float*)a->in[19] + l * DM;
    const float* rw = (const float*)a->in[22]; const float* rbias = (const float*)a->in[23];
    int* ROUTE = (int*)(X.ws + WS_ROUTE);
    LAS float* RWT = (LAS float*)X.lds;
    u32x2 vn[8];
#pragma unroll
    for (int j = 0; j < 8; ++j) vn[j] = *(const u32x2*)(U + (size_t)X.gw * DM + 256 * j + 4 * X.lane);
    {
        f32x4 rv[16];
#pragma unroll
        for (int j = 0; j < 16; ++j) rv[j] = ((const f32x4*)rw)[X.tid + 512 * j];
#pragma unroll
        for (int j = 0; j < 16; ++j) { const int i4 = X.tid + 512 * j, e0 = 4 * (i4 & 3), k = i4 >> 2;
#pragma unroll
            for (int c = 0; c < 4; ++c) RWT[(e0 + c) * DM + k] = rv[j][c]; }
    }
    __syncthreads();
    float bias[16];
#pragma unroll
    for (int e = 0; e < 16; ++e) bias[e] = rbias[e];
    f32x4 v[8];
#pragma unroll
    for (int j = 0; j < 8; ++j) v[j] = up_bf4(vn[j]);
    for (int t = X.gw; t < T; t += X.NGW) { const int b = t >> 12; f32x4 pg[8], pb[8];
        const float* mb = MOD + (size_t)(l * 2 + b) * 12288;
#pragma unroll
        for (int j = 0; j < 8; ++j) { const int c = 256 * j + 4 * X.lane; pg[j] = *(const f32x4*)(lg + c); pb[j] = *(const f32x4*)(lb + c); }
        asm volatile("" ::: "memory");
        if (t + X.NGW < T) {
#pragma unroll
            for (int j = 0; j < 8; ++j) vn[j] = *(const u32x2*)(U + (size_t)(t + X.NGW) * DM + 256 * j + 4 * X.lane); }
        asm volatile("" ::: "memory");
        float mean, rstd; row_stats(v, mean, rstd);
#pragma unroll
        for (int j = 0; j < 8; ++j) v[j] = (v[j] - mean) * rstd * pg[j] + pb[j];
#pragma unroll
        for (int j = 0; j < 8; ++j) { const int c = 256 * j + 4 * X.lane; pg[j] = *(const f32x4*)(mb + 4 * DM + c); pb[j] = *(const f32x4*)(mb + 3 * DM + c); }
        asm volatile("" ::: "memory");
#pragma unroll
        for (int j = 0; j < 8; ++j) __builtin_nontemporal_store(pk_bf4(v[j]), (u32x2*)(XC + (size_t)t * DM + 256 * j + 4 * X.lane));
        asm volatile("" ::: "memory");
        row_stats(v, mean, rstd);
        { unsigned char* hrow = H + (size_t)t * HROWB;
#pragma unroll
          for (int j = 0; j < 8; ++j) { const int c = 256 * j + 4 * X.lane;
            v[j] = (v[j] - mean) * rstd * (pg[j] + 1.0f) + pb[j];
            if constexpr (F8P) *(unsigned*)(hrow + c) = pack4_fp8(v[j][0], v[j][1], v[j][2], v[j][3]);
            else { u32x2 w; w.x = cvt_pk_bf16(v[j][0], v[j][1]); w.y = cvt_pk_bf16(v[j][2], v[j][3]); *(u32x2*)(hrow + 2 * c) = w; } } }
        asm volatile("" ::: "memory");
        float sc[16];
        { f32x4 w[8];
#pragma unroll
          for (int j = 0; j < 8; ++j) w[j] = *(const LAS f32x4*)(RWT + 256 * j + 4 * X.lane);
#pragma unroll
          for (int e = 0; e < 16; ++e) { f32x4 wn[8];
            if (e < 15) {
#pragma unroll
                for (int j = 0; j < 8; ++j) wn[j] = *(const LAS f32x4*)(RWT + (e + 1) * DM + 256 * j + 4 * X.lane); }
            asm volatile("" ::: "memory");
            float s = 0.f;
#pragma unroll
            for (int j = 0; j < 8; ++j) s += (v[j][0] * w[j][0] + v[j][1] * w[j][1]) + (v[j][2] * w[j][2] + v[j][3] * w[j][3]);
            sc[e] = wave_sum(s);
            if (e < 15) {
#pragma unroll
                for (int j = 0; j < 8; ++j) w[j] = wn[j]; } } }
#pragma unroll
        for (int e = 0; e < 16; ++e) sc[e] = sigmoidf_(sc[e]);
        float gs[4]; int i0[4], i1[4];
#pragma unroll
        for (int g = 0; g < 4; ++g) { const float b0 = sc[4 * g] + bias[4 * g], b1 = sc[4 * g + 1] + bias[4 * g + 1], b2 = sc[4 * g + 2] + bias[4 * g + 2], b3 = sc[4 * g + 3] + bias[4 * g + 3];
            float m0 = b0; int a0 = 0; if (b1 > m0) { m0 = b1; a0 = 1; } if (b2 > m0) { m0 = b2; a0 = 2; } if (b3 > m0) { m0 = b3; a0 = 3; }
            float m1 = -3e38f; int a1 = 0;
            if (a0 != 0 && b0 > m1) { m1 = b0; a1 = 0; } if (a0 != 1 && b1 > m1) { m1 = b1; a1 = 1; } if (a0 != 2 && b2 > m1) { m1 = b2; a1 = 2; } if (a0 != 3 && b3 > m1) { m1 = b3; a1 = 3; }
            gs[g] = m0 + m1; i0[g] = 4 * g + a0; i1[g] = 4 * g + a1; }
        int best = 0; float bg = gs[0];
#pragma unroll
        for (int g = 1; g < 4; ++g) if (gs[g] > bg) { bg = gs[g]; best = g; }
        int e0 = i0[0], e1 = i1[0];
#pragma unroll
        for (int g = 1; g < 4; ++g) if (best == g) { e0 = i0[g]; e1 = i1[g]; }
        float w0 = 0.f, w1 = 0.f;
#pragma unroll
        for (int e = 0; e < 16; ++e) { if (e0 == e) w0 = sc[e]; if (e1 == e) w1 = sc[e]; }
        const float inv = 1.0f / (w0 + w1); w0 *= inv; w1 *= inv;
        if (X.lane == 0) { int* rp = ROUTE + (size_t)t * 8; rp[0] = e0; rp[2] = e1; rp[4] = __float_as_int(w0); rp[5] = __float_as_int(w1); ((int*)(X.ws + WS_RT8))[t] = e0 | (e1 << 8); }
        asm volatile("" ::: "memory");
        if (t + X.NGW < T) {
#pragma unroll
            for (int j = 0; j < 8; ++j) v[j] = up_bf4(vn[j]); }
    }
    __syncthreads();
}
__device__ __forceinline__ int build_expert_tables(const Ctx& X, int l, const LAS int* lcnt = nullptr) {
    const int* CNT = (const int*)(X.ws + WS_CTL) + CW_CNT + 64 * l;
    LAS int* base = (LAS int*)(X.lds + L_BASE); LAS int* tab = (LAS int*)(X.lds + L_TILEEXP);
    LAS int* gcnt = (LAS int*)(X.lds + L_BASE) + 48;
    __syncthreads();
    if (!lcnt) { if (X.tid < 16) gcnt[X.tid] = __hip_atomic_load(CNT + X.tid, __ATOMIC_RELAXED, __HIP_MEMORY_SCOPE_AGENT); __syncthreads(); lcnt = gcnt; }
    if (X.tid < 128) { int p = 0, mine = -1; const int row = X.tid * 256;
        for (int e = 0; e < 16; ++e) { const int c = lcnt[e]; const int pe = (c + 255) & ~255;
            if (X.tid == e) { base[e] = p; base[32 + e] = c; } if (row >= p && row < p + pe) mine = e; p += pe; }
        if (X.tid == 16) base[16] = p;
        tab[X.tid] = mine < 0 ? 0 : mine; }
    __syncthreads();
    int total = base[16]; if (total > MAXROWS) total = MAXROWS;
    return total >> 8;
}
__device__ __forceinline__ int moe_prepare(const Ctx& X, int l) {
    typedef unsigned long long u64_;
    LAS u64_* bm = (LAS u64_*)X.lds;
    LAS int* pre = (LAS int*)(X.lds + 16384);
    LAS int* ctot = (LAS int*)(X.lds + 24576);
    LAS int* cntl = (LAS int*)(X.lds + 26624);
    LAS int* rowtok = (LAS int*)(X.lds + L_ROWTOK); LAS float* rowgw = (LAS float*)(X.lds + L_ROWGW);
    const int* ROUTE = (const int*)(X.ws + WS_ROUTE); int* ROWIDX = (int*)(X.ws + WS_ROWIDX);
    __syncthreads();
    int rt[16]; u32x2 gwt[16];
    { const int* RT8 = (const int*)(X.ws + WS_RT8);
#pragma unroll
      for (int i = 0; i < 16; ++i) { const int t = 64 * (i * 8 + X.wave) + X.lane; rt[i] = RT8[t]; gwt[i] = *(const u32x2*)(ROUTE + (size_t)t * 8 + 4); }
      rowtok[X.tid] = 0; rowgw[X.tid] = 0.f;
#pragma unroll
      for (int i = 0; i < 16; ++i) { const int w = i * 8 + X.wave, e0 = rt[i] & 255, e1 = rt[i] >> 8; u64_ mine = 0;
#pragma unroll
        for (int e = 0; e < 16; ++e) { const u64_ m = __ballot(e0 == e || e1 == e); mine = (X.lane == e) ? m : mine; }
        if (X.lane < 16) bm[X.lane * 128 + w] = mine; } }
    __syncthreads();
    { const int e = X.tid >> 5, j = X.tid & 31; int c[4], sum = 0;
#pragma unroll
      for (int k = 0; k < 4; ++k) { c[k] = __popcll(bm[e * 128 + 4 * j + k]); sum += c[k]; }
      ctot[e * 32 + j] = sum;
      __syncthreads();
      int off = 0;
      for (int q = 0; q < 32; ++q) { const int v = ctot[e * 32 + q]; off += (q < j) ? v : 0; }
      pre[e * 128 + 4 * j] = off; pre[e * 128 + 4 * j + 1] = off + c[0]; pre[e * 128 + 4 * j + 2] = off + c[0] + c[1]; pre[e * 128 + 4 * j + 3] = off + c[0] + c[1] + c[2];
      if (j == 31) cntl[e] = off + sum; }
    __syncthreads();
    if (blockIdx.x == 0 && X.tid < 16) ((int*)(X.ws + WS_CTL) + CW_CNT + 64 * l)[X.tid] = cntl[X.tid];
    const int nrt = build_expert_tables(X, l, cntl);
    const LAS int* base = (const LAS int*)(X.lds + L_BASE);
    const int c = (int)blockIdx.x, nun = nrt * 4, pm0 = (c < nun) ? c / 4 : -1, pm1 = (c + X.G < nun) ? (c + X.G) / 4 : -1;
#pragma unroll
    for (int i = 0; i < 16; ++i) { const int tw = i * 8 + X.wave, t = 64 * tw + X.lane; const u64_ lowm = (1ull << X.lane) - 1ull;
        const bool own = ((X.G & (X.G - 1)) == 0) ? ((t & (X.G - 1)) == c) : ((t % X.G) == c);
#pragma unroll
        for (int k = 0; k < 2; ++k) { const int e = k ? (rt[i] >> 8) : (rt[i] & 255);
            const int slot = base[e] + pre[e * 128 + tw] + __popcll(bm[e * 128 + tw] & lowm), pm = slot >> 8;
            if (pm == pm0 || pm == pm1) { const int idx = (pm == pm0 ? 0 : 256) + (slot & 255); rowtok[idx] = t; rowgw[idx] = __uint_as_float(k ? gwt[i].y : gwt[i].x); }
            if (own) ROWIDX[2 * t + k] = slot; } }
    __syncthreads();
    return nrt;
}
template <bool HNEXT>
__device__ __forceinline__ void phase_final(const Ctx& X, KArgs a, int l, float* out) {
    constexpr bool hnext = HNEXT;
    const float* MOD = (const float*)(X.ws + WS_MOD); unsigned char* H = X.ws + WS_H; const bf16_t* XC = (const bf16_t*)(X.ws + WS_XCUR);
    const bf16_t* OS = (const bf16_t*)(X.ws + WS_ARENA + AR_OS); const int* ROWIDX = (const int*)(X.ws + WS_ROWIDX);
    constexpr int NIT = T / (256 * 8); static_assert(NIT == 4, "four rows per wave");
    int rr0[NIT], rr1[NIT];
#pragma unroll
    for (int i = 0; i < NIT; ++i) { const int t = X.gw + i * X.NGW; rr0[i] = ROWIDX[2 * t]; rr1[i] = ROWIDX[2 * t + 1]; }
    u32x2 xn[8], pn[8], qn[8];
    { const int t = X.gw;
#pragma unroll
      for (int j = 0; j < 8; ++j) { const int c = 256 * j + 4 * X.lane; xn[j] = *(const u32x2*)(XC + (size_t)t * DM + c); pn[j] = *(const u32x2*)(OS + (size_t)rr0[0] * DM + c); qn[j] = *(const u32x2*)(OS + (size_t)rr1[0] * DM + c); } }
    LAS float* PL = (LAS float*)X.lds;
    { const float* srcs[8] = {(const float*)a->in[20] + l * DM, (const float*)a->in[21] + l * DM, MOD + (size_t)(l * 2 + 0) * 12288 + 5 * DM, MOD + (size_t)(l * 2 + 1) * 12288 + 5 * DM,
                              MOD + (size_t)((l + 1) * 2 + 0) * 12288 + 1 * DM, MOD + (size_t)((l + 1) * 2 + 1) * 12288 + 1 * DM, MOD + (size_t)((l + 1) * 2 + 0) * 12288, MOD + (size_t)((l + 1) * 2 + 1) * 12288};
      f32x4 pv[8];
#pragma unroll
      for (int k = 0; k < 8; ++k) pv[k] = (k < 4 || hnext) ? *(const f32x4*)(srcs[k] + 4 * X.tid) : (f32x4){0.f, 0.f, 0.f, 0.f};
#pragma unroll
      for (int k = 0; k < 8; ++k) *(LAS f32x4*)(PL + k * DM + 4 * X.tid) = pv[k]; }
    __syncthreads();
    f32x4 v[8];
#define FIN_COMBINE(bb) do { _Pragma("unroll") for (int j = 0; j < 8; ++j) { const f32x4 x = up_bf4(xn[j]), g = *(const LAS f32x4*)(PL + (2 + (bb)) * DM + 256 * j + 4 * X.lane); const u32x2 p = pn[j], q = qn[j]; \
        f32x4 y; y[0] = bflo(p.x) + bflo(q.x); y[1] = bfhi(p.x) + bfhi(q.x); y[2] = bflo(p.y) + bflo(q.y); y[3] = bfhi(p.y) + bfhi(q.y); v[j] = x * ALPHA + g * y; } } while (0)
    FIN_COMBINE(X.gw >> 12);
#pragma unroll 1
    for (int i = 0; i < NIT; ++i) { const int t = X.gw + i * X.NGW, b = t >> 12;
        if (i + 1 < NIT) { const int tn = t + X.NGW;
            const int rn0 = (i == 0) ? rr0[1] : (i == 1) ? rr0[2] : rr0[3], rn1 = (i == 0) ? rr1[1] : (i == 1) ? rr1[2] : rr1[3];
#pragma unroll
            for (int j = 0; j < 8; ++j) { const int c = 256 * j + 4 * X.lane; xn[j] = *(const u32x2*)(XC + (size_t)tn * DM + c); pn[j] = *(const u32x2*)(OS + (size_t)rn0 * DM + c); qn[j] = *(const u32x2*)(OS + (size_t)rn1 * DM + c); } }
        asm volatile("" ::: "memory");
        float mean, rstd; row_stats(v, mean, rstd);
#pragma unroll
        for (int j = 0; j < 8; ++j) { const int c = 256 * j + 4 * X.lane; v[j] = (v[j] - mean) * rstd * *(const LAS f32x4*)(PL + c) + *(const LAS f32x4*)(PL + DM + c);
            if (hnext) __builtin_nontemporal_store(pk_bf4(v[j]), (u32x2*)((bf16_t*)out + (size_t)t * DM + c)); else __builtin_nontemporal_store(v[j], (f32x4*)(out + (size_t)t * DM + c)); }
        if (hnext) { row_stats(v, mean, rstd); unsigned char* hrow = H + (size_t)t * HROWB;
#pragma unroll
            for (int j = 0; j < 8; ++j) { const int c = 256 * j + 4 * X.lane;
                v[j] = (v[j] - mean) * rstd * (*(const LAS f32x4*)(PL + (4 + b) * DM + c) + 1.0f) + *(const LAS f32x4*)(PL + (6 + b) * DM + c);
                if constexpr (F8P) *(unsigned*)(hrow + c) = pack4_fp8(v[j][0], v[j][1], v[j][2], v[j][3]);
                else { u32x2 w; w.x = cvt_pk_bf16(v[j][0], v[j][1]); w.y = cvt_pk_bf16(v[j][2], v[j][3]); *(u32x2*)(hrow + 2 * c) = w; } } }
        asm volatile("" ::: "memory");
        if (i + 1 < NIT) FIN_COMBINE((t + X.NGW) >> 12);
    }
#undef FIN_COMBINE
    __syncthreads();
}

__device__ __forceinline__ void phase_attention(const Ctx& X, KArgs a, int l) {
    unsigned char* ar = X.ws + WS_ARENA;
    const bf16_t *AQ = (const bf16_t*)(ar + AR_AQ), *AK = (const bf16_t*)(ar + AR_AK), *AV = (const bf16_t*)(ar + AR_AV);
    const bf16_t *QM = (const bf16_t*)(ar + AR_QM), *KM = (const bf16_t*)(ar + AR_KM), *VM = (const bf16_t*)(ar + AR_VM);
    const bf16_t *SWQ = (const bf16_t*)(ar + AR_SWQ), *SWK = (const bf16_t*)(ar + AR_SWK), *SWV = (const bf16_t*)(ar + AR_SWV);
    bf16_t *YA = (bf16_t*)(ar + AR_YABC), *YB = YA + (size_t)T * 1024, *YC = YB + (size_t)T * 1024;
    float* SCR = (float*)(ar + AR_SCR);
    const int tid_ = opaque_tid(X.wave), wid = __builtin_amdgcn_readfirstlane(tid_ >> 6), lane = tid_ & 63, r32 = lane & 31, hi = lane >> 5;
    char* lds = X.ldsg;
    const int c = blockIdx.x, xcd = c & 7, idx = c >> 3;
    if constexpr (PHEN(13)) REP(13) {
        constexpr float C = 0.125f * 1.4426950408889634f, THRR = 8.0f / 0.125f;
        const int per = X.G >> 3;
        for (int u = (X.G == 256) ? (xcd * per + idx) : c; u < 256; u += X.G) {
            const int bh = u >> 4, qb = u & 15, b = bh >> 3, h = bh & 7, q0 = qb * 256;
            f32x16 o[4]; float lsum; float rli[16]; f32x16 lrow;
            if constexpr (QK8A) { constexpr float C8 = C / (S_QK * S_QK);
                att::attn_body_dma<64, 128, false, true, true>((const bf16_t*)((const unsigned char*)AQ + ((size_t)((b * 2 + 0) * 8 + h) * SEQ + q0 + wid * 32) * 64), 64, (const bf16_t*)((const unsigned char*)AK + (size_t)((b * 2 + 0) * 8 + h) * SEQ * 64), 64,
                                               (const bf16_t*)((const unsigned char*)AV + (size_t)(b * 8 + h) * 128 * SEQ), SEQ, SEQ / 64, C8, PV8_THR / C8, -1e30f, 0.f, 0, lds, o, lsum, X.wave, &lrow);
#pragma unroll
                for (int r = 0; r < 16; ++r) rli[r] = __builtin_amdgcn_rcpf(lrow[r]) * (1.0f / S_V); }
            else if constexpr (PV8A) { att::attn_body_dma<64, 128, false, true>(AQ + ((size_t)((b * 2 + 0) * 8 + h) * SEQ + q0 + wid * 32) * 64, 64, AK + (size_t)((b * 2 + 0) * 8 + h) * SEQ * 64, 64,
                                               (const bf16_t*)((const unsigned char*)AV + (size_t)(b * 8 + h) * 128 * SEQ), SEQ, SEQ / 64, C, PV8_THR / C, -1e30f, 0.f, 0, lds, o, lsum, X.wave, &lrow);
#pragma unroll
                for (int r = 0; r < 16; ++r) rli[r] = __builtin_amdgcn_rcpf(lrow[r]) * (1.0f / S_V); }
            else { att::attn_body_dma<64, 128, false>(AQ + ((size_t)((b * 2 + 0) * 8 + h) * SEQ + q0 + wid * 32) * 64, 64, AK + (size_t)((b * 2 + 0) * 8 + h) * SEQ * 64, 64,
                                               AV + (size_t)(b * 8 + h) * SEQ * 128, 128, SEQ / 64, C, THRR, -1e30f, 0.f, 0, lds, o, lsum, X.wave);
                att::row_rcp(lsum, lds, 3 * (64 * 128 * 2 + 64 * 64 * 2), rli, X.wave); }
            GAS f32x4* scr = opaque_ptr((f32x4*)(SCR + ((size_t)(blockIdx.x * 8 + wid) * 64 + lane) * 64));
#pragma unroll
            for (int d = 0; d < 4; ++d)
#pragma unroll
                for (int q = 0; q < 4; ++q) scr[d * 4 + q] = (f32x4){o[d][4 * q] * rli[4 * q], o[d][4 * q + 1] * rli[4 * q + 1], o[d][4 * q + 2] * rli[4 * q + 2], o[d][4 * q + 3] * rli[4 * q + 3]};
            if constexpr (QK8A) { constexpr float C8 = C / (S_QK * S_QK);
                att::attn_body_dma<64, 128, false, true, true>((const bf16_t*)((const unsigned char*)AQ + ((size_t)((b * 2 + 1) * 8 + h) * SEQ + q0 + wid * 32) * 64), 64, (const bf16_t*)((const unsigned char*)AK + (size_t)((b * 2 + 1) * 8 + h) * SEQ * 64), 64,
                                               (const bf16_t*)((const unsigned char*)AV + (size_t)(b * 8 + h) * 128 * SEQ), SEQ, SEQ / 64, C8, PV8_THR / C8, -1e30f, 0.f, 0, lds, o, lsum, X.wave, &lrow);
#pragma unroll
                for (int r = 0; r < 16; ++r) rli[r] = __builtin_amdgcn_rcpf(lrow[r]) * (1.0f / S_V); }
            else if constexpr (PV8A) { att::attn_body_dma<64, 128, false, true>(AQ + ((size_t)((b * 2 + 1) * 8 + h) * SEQ + q0 + wid * 32) * 64, 64, AK + (size_t)((b * 2 + 1) * 8 + h) * SEQ * 64, 64,
                                               (const bf16_t*)((const unsigned char*)AV + (size_t)(b * 8 + h) * 128 * SEQ), SEQ, SEQ / 64, C, PV8_THR / C, -1e30f, 0.f, 0, lds, o, lsum, X.wave, &lrow);
#pragma unroll
                for (int r = 0; r < 16; ++r) rli[r] = __builtin_amdgcn_rcpf(lrow[r]) * (1.0f / S_V); }
            else { att::attn_body_dma<64, 128, false>(AQ + ((size_t)((b * 2 + 1) * 8 + h) * SEQ + q0 + wid * 32) * 64, 64, AK + (size_t)((b * 2 + 1) * 8 + h) * SEQ * 64, 64,
                                               AV + (size_t)(b * 8 + h) * SEQ * 128, 128, SEQ / 64, C, THRR, -1e30f, 0.f, 0, lds, o, lsum, X.wave);
                att::row_rcp(lsum, lds, 3 * (64 * 128 * 2 + 64 * 64 * 2), rli, X.wave); }
            asm volatile("s_waitcnt vmcnt(0)" ::: "memory");
            const float lam_init = (l == 0) ? 0.2f : 0.35550906759096f;
            const GAS float* lq = opaque_ptr((const float*)a->in[4] + l * 128); const float* lk = (const float*)a->in[5] + l * 128;
            const float e0 = __expf(wave_sum(lq[lane] * lk[lane])), e1 = __expf(wave_sum(lq[64 + lane] * lk[64 + lane]));
            const float lam = e0 - e1 + lam_init;
            const GAS float* sg = opaque_ptr((const float*)a->in[6] + l * 128);
            float sub[4];
#pragma unroll
            for (int d = 0; d < 4; ++d) sub[d] = sg[32 * d + r32] * (1.0f - lam_init);
            const GAS f32x4* scr2 = opaque_ptr((const f32x4*)(SCR + ((size_t)(blockIdx.x * 8 + wid) * 64 + lane) * 64));
#pragma unroll
            for (int d = 0; d < 4; ++d)
#pragma unroll
                for (int q = 0; q < 4; ++q) { const f32x4 o1 = scr2[d * 4 + q];
#pragma unroll
                    for (int j = 0; j < 4; ++j) o[d][4 * q + j] = o1[j] - lam * (o[d][4 * q + j] * rli[4 * q + j]); }
            GAS bf16_t* ybase = opaque_ptr(YA + (size_t)(b * SEQ + q0 + wid * 32 + 4 * hi) * 1024 + h * 128 + r32);
            GAS unsigned char* y8base = opaque_ptr((unsigned char*)YA + (size_t)(b * SEQ + q0 + wid * 32 + 4 * hi) * 3072 + 0 * 1024 + h * 128 + r32);
#pragma unroll
            for (int r = 0; r < 16; ++r) { float ss = (o[0][r] * o[0][r] + o[1][r] * o[1][r]) + (o[2][r] * o[2][r] + o[3][r] * o[3][r]);
                ss = xor16_sum(row16_sum(ss));
                const float rs = 1.0f / sqrtf(ss * (1.0f / 128.0f) + RMS_EPS);
                GAS bf16_t* yp = ybase + (size_t)((r & 3) + 8 * (r >> 2)) * 1024; GAS unsigned char* yp8 = y8base + (size_t)((r & 3) + 8 * (r >> 2)) * 3072;
#pragma unroll
                for (int d = 0; d < 4; ++d) { if constexpr (F8B) yp8[32 * d] = fp8_byte(o[d][r] * rs * sub[d] * S_YA); else yp[32 * d] = (bf16_t)(cvt_pk_bf16(o[d][r] * rs * sub[d], 0.f) & 0xffffu); } }
        }
    }
    if constexpr (PHEN(14)) REP(14) {
        constexpr float SC = 0.07216878364870322f, C = SC * 1.4426950408889634f, THRR = 8.0f / SC;
        const int per = X.G >> 3;
        for (int u = (X.G == 256) ? (xcd * per + idx) : c; u < 256; u += X.G) {
            const int bh = u >> 4, qb = u & 15, b = bh >> 3, h = bh & 7, q0 = qb * 256;
            f32x16 o[4]; float lsum; float rli[16]; f32x16 lrow;
            if constexpr (QK8B) { constexpr float C8 = C / (S_QK * S_QK);
                att::attn_body_dma<192, 128, false, true, true>((const bf16_t*)((const unsigned char*)QM + ((size_t)bh * SEQ + q0 + wid * 32) * 192), 192, (const bf16_t*)((const unsigned char*)KM + (size_t)bh * SEQ * 192), 192,
                                                (const bf16_t*)((const unsigned char*)VM + (size_t)bh * 128 * SEQ), SEQ, SEQ / 64, C8, PV8_THR / C8, -1e30f, 0.f, 0, lds, o, lsum, X.wave, &lrow);
#pragma unroll
                for (int r = 0; r < 16; ++r) rli[r] = __builtin_amdgcn_rcpf(lrow[r]) * (1.0f / S_V); }
            else if constexpr (PV8B) { att::attn_body_dma<192, 128, false, true>(QM + ((size_t)bh * SEQ + q0 + wid * 32) * 192, 192, KM + (size_t)bh * SEQ * 192, 192,
                                                (const bf16_t*)((const unsigned char*)VM + (size_t)bh * 128 * SEQ), SEQ, SEQ / 64, C, PV8_THR / C, -1e30f, 0.f, 0, lds, o, lsum, X.wave, &lrow);
#pragma unroll
                for (int r = 0; r < 16; ++r) rli[r] = __builtin_amdgcn_rcpf(lrow[r]) * (1.0f / S_V); }
            else { att::attn_body_dma<192, 128, false>(QM + ((size_t)bh * SEQ + q0 + wid * 32) * 192, 192, KM + (size_t)bh * SEQ * 192, 192, VM + (size_t)bh * SEQ * 128, 128, SEQ / 64,
                                                C, THRR, -1e30f, 0.f, 0, lds, o, lsum, X.wave);
                att::row_rcp(lsum, lds, 3 * (64 * 128 * 2 + 64 * 192 * 2), rli, X.wave); }
            GAS bf16_t* ybase = opaque_ptr(YB + (size_t)(b * SEQ + q0 + wid * 32 + 4 * hi) * 1024 + h * 128 + r32);
            GAS unsigned char* y8base = opaque_ptr((unsigned char*)YA + (size_t)(b * SEQ + q0 + wid * 32 + 4 * hi) * 3072 + 1 * 1024 + h * 128 + r32);
#pragma unroll
            for (int r = 0; r < 16; ++r) { GAS bf16_t* yp = ybase + (size_t)((r & 3) + 8 * (r >> 2)) * 1024; GAS unsigned char* yp8 = y8base + (size_t)((r & 3) + 8 * (r >> 2)) * 3072;
#pragma unroll
                for (int d = 0; d < 4; ++d) { if constexpr (F8B) yp8[32 * d] = fp8_byte(o[d][r] * rli[r] * S_YB); else yp[32 * d] = (bf16_t)(cvt_pk_bf16(o[d][r] * rli[r], 0.f) & 0xffffu); } }
        }
    }
    if constexpr (PHEN(15)) REP(15) {
        constexpr float SC = 0.125f, C = SC * 1.4426950408889634f, THRR = 8.0f / SC;
        const float* sink = (const float*)a->in[11] + l * 16;
        for (int u = c; u < 512; u += X.G) {
            const int pr = u & 1, qblk = (u >> 1) & 31, kvh = (u >> 6) & 3, b = u >> 8;
            const int hq = kvh * 4 + 2 * pr + (wid >> 2), q0 = qblk * 128;
            const int key0 = (q0 - 128 < 0) ? 0 : q0 - 128, key1 = (q0 + 256 > SEQ) ? SEQ : q0 + 256, NT = (key1 - key0) >> 6;
            const int qw = q0 + (wid & 3) * 32;
            f32x16 o[2]; float lsum; float rli[16];
            if constexpr (PV8C) { constexpr float C8 = C / (S_QK * S_QK); f32x16 lrow;
                att::attn_body_dma<64, 64, true, true, true>((const bf16_t*)((const unsigned char*)SWQ + ((size_t)(b * 16 + hq) * SEQ + qw) * 64), 64, (const bf16_t*)((const unsigned char*)SWK + ((size_t)(b * 4 + kvh) * SEQ + key0) * 64), 64,
                                            (const bf16_t*)((const unsigned char*)SWV + (size_t)(b * 4 + kvh) * 64 * SEQ + key0), SEQ, NT, C8, PV8_THR / C8, sink[hq] * 8.0f * (S_QK * S_QK), 1.0f, qw - key0, lds, o, lsum, X.wave, &lrow);
#pragma unroll
                for (int r = 0; r < 16; ++r) rli[r] = __builtin_amdgcn_rcpf(lrow[r]) * (1.0f / S_V); }
            else {
            att::attn_body<64, 64, 2, true>(SWQ + ((size_t)(b * 16 + hq) * SEQ + qw) * 64, 64, SWK + ((size_t)(b * 4 + kvh) * SEQ + key0) * 64, 64,
                                            SWV + ((size_t)(b * 4 + kvh) * SEQ + key0) * 64, 64, NT, C, THRR, sink[hq] * 8.0f, 1.0f, qw - key0, lds, o, lsum, X.wave);
            att::row_rcp(lsum, lds, 2 * 64 * 64 * 2 + 2 * 64 * 64 * 2, rli, X.wave); }
            GAS bf16_t* ybase = opaque_ptr(YC + (size_t)(b * SEQ + qw + 4 * hi) * 1024 + hq * 64 + r32);
            GAS unsigned char* y8base = opaque_ptr((unsigned char*)YA + (size_t)(b * SEQ + qw + 4 * hi) * 3072 + 2 * 1024 + hq * 64 + r32);
#pragma unroll
            for (int r = 0; r < 16; ++r) { GAS bf16_t* yp = ybase + (size_t)((r & 3) + 8 * (r >> 2)) * 1024; GAS unsigned char* yp8 = y8base + (size_t)((r & 3) + 8 * (r >> 2)) * 3072;
#pragma unroll
                for (int d = 0; d < 2; ++d) { if constexpr (F8B) yp8[32 * d] = fp8_byte(o[d][r] * rli[r] * S_YC); else yp[32 * d] = (bf16_t)(cvt_pk_bf16(o[d][r] * rli[r], 0.f) & 0xffffu); } }
        }
    }
    __syncthreads();
}

constexpr int PH_PER_LAYER = 11, N_PHASES = 1 + DEPTH * PH_PER_LAYER;
__global__ void __launch_bounds__(512, 2) mk_fwd(Args args) {
    extern __shared__ __attribute__((aligned(16))) unsigned char lds_raw[];
    Ctx X;
    X.lds = (LAS unsigned char*)lds_raw; X.ldsg = (char*)lds_raw;
    X.tid = threadIdx.x; X.lane = X.tid & 63; X.wave = __builtin_amdgcn_readfirstlane(X.tid >> 6);
    X.G = gridDim.x; X.gw = blockIdx.x * 8 + X.wave; X.NGW = X.G * 8; X.ws = get_ka()->ws;
    for (int u = X.tid; u < (LDS_BYTES - LDSCTL_OFF) / 4; u += 512) ((LAS unsigned*)(X.lds + LDSCTL_OFF))[u] = 0u;
    __syncthreads();
    unsigned* ctl = (unsigned*)(X.ws + WS_CTL);
    XcdBarrier bar; bar.bar = ctl + CW_BAR; bar.x = 0; bar.st = nullptr;
#if !MK_PER_PHASE
    bar = xcd_barrier_post(ctl + CW_BAR, (volatile LAS unsigned*)(X.lds + L_MISC) + 8);
#endif
    const int lo = get_ka()->ph_lo, hi = get_ka()->ph_hi;
#define IN(k) (lo <= (k) && (k) < hi)
#if MK_PER_PHASE
#define SEAM(k) do { } while (0)
#else
#define SEAM(k) do { if ((k) + 1 < hi) { xcd_barrier(bar); if (((MK_REPEAT) >> 16) & 1u) xcd_barrier(bar); } } while (0)
#endif
    unsigned char* ar; const float* COS; const float* SIN; float* SSQQ; float* SSQK; const float* MOD; bf16_t* H;

#define REFRESH() do { const int t_ = opaque_tid(X.wave); X.tid = t_; X.lane = t_ & 63; \
        { GAS unsigned char* g_ = (GAS unsigned char*)X.ws; asm volatile("" : "+s"(g_)); X.ws = (unsigned char*)g_; }     \
        ar = X.ws + WS_ARENA; COS = (const float*)(X.ws + WS_COS); SIN = (const float*)(X.ws + WS_SIN); SSQQ = (float*)(X.ws + WS_SSQQ); SSQK = (float*)(X.ws + WS_SSQK); \
        MOD = (const float*)(X.ws + WS_MOD); H = (bf16_t*)(X.ws + WS_H); } while (0)
    if (IN(0)) { if constexpr (PHEN(0)) REP(0) { phase_prologue(X, get_ka()); __syncthreads(); } SEAM(0); }

    for (int l = 0; l < DEPTH; ++l) {
        const int pb = 1 + l * PH_PER_LAYER;
#define WB() (X.ws + WS_W + (size_t)l * W_STRIDE)
#define XIN() ((l == 0) ? (const float*)get_ka()->in[0] : (const float*)(X.ws + WS_XCUR))
        if (IN(pb + 0) && l == 0) { REFRESH(); if constexpr (PHEN(1)) phase_ln1(X, XIN(), l); SEAM(pb + 0); }
        if (IN(pb + 1)) { REFRESH();
            pg8::Gemm g{H, (const bf16_t*)(WB() + WO_WIN), F8P ? DM / 2 : DM}; pg8::StaticOrder S; S.init(T, NPROJ, X.G, (int)blockIdx.x);
            pg8::EpiProj E{(bf16_t*)(ar + AR_AQ), (bf16_t*)(ar + AR_AK), (bf16_t*)(ar + AR_AV), (bf16_t*)(ar + AR_CQ), (bf16_t*)(ar + AR_CKV), (bf16_t*)(ar + AR_SWQ), (bf16_t*)(ar + AR_SWK),
                           (bf16_t*)(ar + AR_SWV), (bf16_t*)(ar + AR_GATES), (bf16_t*)(ar + AR_KM), SSQQ, SSQK, COS, SIN};
            if constexpr (PHEN(2)) REP(2) pg8::gemm_phase<pg8::EpiProj, pg8::StaticOrder, F8P, true, true>(X.lds, g, S, E, X.wave);
            { const int nfull = (S.nwg / X.G) * X.G, n6 = S.nwg - nfull;
              if (n6 == 0 || (int)blockIdx.x >= n6) { if (l == 0) convert_range(X, get_ka(), D0_ABC0, D0_ABC1, ((int)blockIdx.x - n6) * 8 + X.wave, (X.G - n6) * 8);
                                                      else convert_range(X, get_ka(), D_UQ1, D_ABC1, ((int)blockIdx.x - n6) * 8 + X.wave, (X.G - n6) * 8); } }
            SEAM(pb + 1);
        }
        if (IN(pb + 2)) { REFRESH();
            { pg8::Gemm g{(const bf16_t*)(ar + AR_CQ), (const bf16_t*)(WB() + WO_WUQ), F8U ? 256 : 512, 1.0f / (64.0f * S_C)}; pg8::StaticOrder S; S.init(T, 1536, X.G, (int)blockIdx.x);
              pg8::EpiUq E{(bf16_t*)(ar + AR_QM), SSQQ, COS, SIN};
              if constexpr (PHEN(3)) REP(3) pg8::gemm_phase<pg8::EpiUq, pg8::StaticOrder, F8U>(X.lds, g, S, E, X.wave); }
            { pg8::Gemm g{(const bf16_t*)(ar + AR_CKV), (const bf16_t*)(WB() + WO_WUKV), F8U ? 128 : 256, 1.0f / (64.0f * S_C)}; pg8::StaticOrder S; S.init(T, 2048, X.G, (int)blockIdx.x);
              pg8::EpiUkv E{(bf16_t*)(ar + AR_KM), (bf16_t*)(ar + AR_VM), SSQK};
              if constexpr (PHEN(4)) REP(3) pg8::gemm_phase<pg8::EpiUkv, pg8::StaticOrder, F8U>(X.lds, g, S, E, X.wave); }
            if (X.G == 256 && (int)blockIdx.x >= 192) { if (l == 0) convert_range(X, get_ka(), D0_ABC1, D0_WOA, ((int)blockIdx.x - 192) * 8 + X.wave, 512);
                                                          else convert_range(X, get_ka(), D_WO1, D_W13A, ((int)blockIdx.x - 192) * 8 + X.wave, 512); }
            else if (X.G != 256) { if (l == 0) convert_range(X, get_ka(), D0_ABC1, D0_WOA, X.gw, X.NGW); else convert_range(X, get_ka(), D_WO1, D_W13A, X.gw, X.NGW); }
            SEAM(pb + 2);
        }
        if (IN(pb + 3)) { REFRESH(); if constexpr (PHEN(5)) phase_attention(X, get_ka(), l); SEAM(pb + 3); }
        if (IN(pb + 4)) { REFRESH();
            pg8::EpiBranch E{(bf16_t*)(ar + AR_Y), (const bf16_t*)(ar + AR_GATES), ar + AR_SCR};
            if constexpr (F8B) { pg8::Gemm g{(const bf16_t*)(ar + AR_YABC), (const bf16_t*)(WB() + WO_WABC), 1536}; pg8::StaticOrder S; S.init(T, DM, X.G, (int)blockIdx.x);
                if constexpr (PHEN(6)) REP(6) pg8::gemm_phase<pg8::EpiBranch, pg8::StaticOrder, true>(X.lds, g, S, E, X.wave); }
            else { pg8::Gemm g{(const bf16_t*)(ar + AR_YABC), (const bf16_t*)(WB() + WO_WABC), 1024}; pg8::BranchOrder S; S.init(T, DM, X.G, (int)blockIdx.x); S.rowsA = T; S.rowsB = DM;
                if constexpr (PHEN(6)) REP(6) { if (X.G == 256) pg8::gemm_phase<pg8::EpiBranch, pg8::BranchOrder, false>(X.lds, g, S, E, X.wave); } }
            SEAM(pb + 4);
        }
        if (IN(pb + 5)) { REFRESH();
            pg8::Gemm g{(const bf16_t*)(ar + (F8B ? AR_SCR : AR_Y)), (const bf16_t*)(WB() + WO_WO), F8B ? DM / 2 : DM, 1.0f / (64.0f * S_Y)}; pg8::StaticOrder S; S.init(T, DM, X.G, (int)blockIdx.x);
            pg8::EpiOut E{(const bf16_t*)(X.ws + WS_XCUR), (bf16_t*)(X.ws + WS_U), MOD + (size_t)(l * 2) * 12288 + 2 * DM};
            if constexpr (PHEN(7)) REP(7) pg8::gemm_phase<pg8::EpiOut, pg8::StaticOrder, F8B>(X.lds, g, S, E, X.wave);
            SEAM(pb + 5);
        }
        if (IN(pb + 6)) { REFRESH(); if constexpr (PHEN(8)) REP(8) phase_ln2_route(X, get_ka(), l); SEAM(pb + 6); }
        if (IN(pb + 8)) { REFRESH();
            if constexpr (PHEN(10)) REP(10) {
            const int nrt = moe_prepare(X, l);
            pg8::Gemm g{(const bf16_t*)(X.ws + WS_H), (const bf16_t*)(WB() + WO_W13), F8M ? DM / 2 : DM};
            pg8::GroupedGatherOrder S{{(const LAS int*)(X.lds + L_TILEEXP), nrt, 4, X.G, (int)blockIdx.x, 1024}, (const LAS int*)(X.lds + L_ROWTOK)};
            pg8::EpiMoeUp E{(bf16_t*)(ar + AR_HID), (const LAS float*)(X.lds + L_ROWGW)};
            pg8::gemm_phase<pg8::EpiMoeUp, pg8::GroupedGatherOrder, F8M, true, true>(X.lds, g, S, E, X.wave);
            { const int n2 = nrt * 4 - X.G > 0 ? nrt * 4 - X.G : 0;
                if ((int)blockIdx.x >= n2 && n2 < X.G) { if (l == 0) convert_range(X, get_ka(), D_WIN0, D_WIN1, ((int)blockIdx.x - n2) * 8 + X.wave, (X.G - n2) * 8); else convert_range(X, get_ka(), D_W20, D_W21, ((int)blockIdx.x - n2) * 8 + X.wave, (X.G - n2) * 8); } } }
            SEAM(pb + 8);
        }
        if (IN(pb + 9)) { REFRESH();
            const int nrt = build_expert_tables(X, l);
            pg8::Gemm g{(const bf16_t*)(ar + AR_HID), (const bf16_t*)(WB() + WO_W2), F8D ? EH / 2 : EH, 1.0f / (64.0f * S_HID)};
            pg8::GroupedOrder S{(const LAS int*)(X.lds + L_TILEEXP), nrt, 8, X.G, (int)blockIdx.x, DM};
            pg8::EpiMoeDown E{(bf16_t*)(ar + AR_OS)};
            if constexpr (PHEN(11)) REP(11) pg8::gemm_phase<pg8::EpiMoeDown, pg8::GroupedOrder, F8D>(X.lds, g, S, E, X.wave);
            if (l == 0) { const int nun = nrt * 8, nfull = (nun / X.G) * X.G, n3 = nun - nfull;
                if (n3 > 0 && (int)blockIdx.x >= n3) { convert_range(X, get_ka(), D_WIN1, D_UQ1, ((int)blockIdx.x - n3) * 8 + X.wave, (X.G - n3) * 8); convert_range(X, get_ka(), D_ABC1, D_WO1, ((int)blockIdx.x - n3) * 8 + X.wave, (X.G - n3) * 8); convert_range(X, get_ka(), D_W13A, D_W13B, ((int)blockIdx.x - n3) * 8 + X.wave, (X.G - n3) * 8); }
                else if (n3 == 0) { convert_range(X, get_ka(), D_WIN1, D_UQ1, X.gw, X.NGW); convert_range(X, get_ka(), D_ABC1, D_WO1, X.gw, X.NGW); convert_range(X, get_ka(), D_W13A, D_W13B, X.gw, X.NGW); } }
            SEAM(pb + 9);
        }
        if (IN(pb + 10)) { REFRESH(); const bool lastl = (l == DEPTH - 1); if constexpr (PHEN(12)) for (int rep_ = 0; rep_ < 1 + (int)((((MK_REPEAT) >> 12) & 1u) && lastl); ++rep_) { if (lastl) phase_final<false>(X, get_ka(), l, get_ka()->out); else phase_final<true>(X, get_ka(), l, (float*)(X.ws + WS_XCUR)); }     SEAM(pb + 10); }
    }
#undef IN
#undef SEAM
}

extern "C" void kernel_launch(void* const* d_in, const int* in_sizes, int n_in, void* d_out, int out_size, void* d_ws, size_t ws_size, hipStream_t stream) {
    static int grid = 0;
    if (grid == 0) {
        if (n_in != 27 || out_size != T * DM || ws_size < WS_END) { fprintf(stderr, "kernel_launch: unexpected shapes (n_in %d, out %d, ws %zu, need %zu)\n", n_in, out_size, ws_size, (size_t)WS_END); grid = -1; return; }
        int dev = 0, cus = 0, per_cu = 0;
        if (hipGetDevice(&dev) != hipSuccess || hipDeviceGetAttribute(&cus, hipDeviceAttributeMultiprocessorCount, dev) != hipSuccess) { grid = -1; return; }
        if (hipFuncSetAttribute((const void*)mk_fwd, hipFuncAttributeMaxDynamicSharedMemorySize, LDS_BYTES) != hipSuccess) { fprintf(stderr, "kernel_launch: hipFuncSetAttribute failed\n"); grid = -1; return; }
        if (hipOccupancyMaxActiveBlocksPerMultiprocessor(&per_cu, (const void*)mk_fwd, 512, LDS_BYTES) != hipSuccess || per_cu < 1) { fprintf(stderr, "kernel_launch: occupancy query says %d\n", per_cu); }
        (void)hipGetLastError();
        grid = cus;
        if (grid != 256) fprintf(stderr, "kernel_launch: %d CUs (the branch phase needs 256)\n", grid);
    }
    if (grid < 0) return;
    (void)hipMemsetAsync((char*)d_ws + WS_CTL, 0, CTL_ZERO_BYTES, stream);
    Args a{};
    for (int i = 0; i < 27; ++i) a.in[i] = d_in[i];
    a.out = (float*)d_out; a.ws = (unsigned char*)d_ws;
#if MK_PER_PHASE
    for (int p = 0; p < N_PHASES; ++p) { a.ph_lo = p; a.ph_hi = p + 1; hipLaunchKernelGGL(mk_fwd, dim3(grid), dim3(512), LDS_BYTES, stream, a); }
#else
    a.ph_lo = 0; a.ph_hi = N_PHASES;
    hipLaunchKernelGGL(mk_fwd, dim3(grid), dim3(512), LDS_BYTES, stream, a);
#endif
}
```

```cpp
#include <hip/hip_runtime.h>
#include <cstdio>
#include <cstdint>

#ifndef MK_PER_PHASE
#define MK_PER_PHASE 0
#endif
#ifndef MK_FP8
#define MK_FP8 31
#endif
#ifndef MK_F8_RESCALE
#define MK_F8_RESCALE 0.015625f
#endif
#ifndef MK_F8_NOSCALE
#define MK_F8_NOSCALE 0
#endif
#ifndef MK_PHASE_MASK
#define MK_PHASE_MASK 0xFFFFu
#endif
#define PHEN(k) (((MK_PHASE_MASK) >> (k)) & 1u)
#ifndef MK_REPEAT
#define MK_REPEAT 0u
#endif
#define REP(k) for (int rep_ = 0; rep_ < 1 + (int)(((MK_REPEAT) >> (k)) & 1u); ++rep_)

#define GAS __attribute__((address_space(1)))
#define LAS __attribute__((address_space(3)))
typedef unsigned short bf16_t;
typedef short bf16x8 __attribute__((ext_vector_type(8)));
typedef short s16x4 __attribute__((ext_vector_type(4)));
typedef float f32x2 __attribute__((ext_vector_type(2)));
typedef float f32x4 __attribute__((ext_vector_type(4)));
typedef float f32x16 __attribute__((ext_vector_type(16)));
typedef unsigned u32x2 __attribute__((ext_vector_type(2)));
typedef unsigned u32x4 __attribute__((ext_vector_type(4)));

constexpr int DM = 2048, NB = 2, SEQ = 4096, T = NB * SEQ, DEPTH = 2;
constexpr int NPROJ = 11776;
constexpr int IN_WIDTH = 11584;
constexpr int OFF_AQ = 0, OFF_AK = 1024, OFF_AV = 2048, OFF_CQ = 3072, OFF_CKV = 3584, OFF_KR = 3840, OFF_SWQ = 3904, OFF_SWK = 4928, OFF_SWV = 5184, OFF_GATE = 5440;
constexpr int NEXP = 16, EH = 512;
constexpr float LN_EPS = 1e-5f, RMS_EPS = 1e-6f;
constexpr float ALPHA = 1.4142135623730951f;
constexpr int MAXROWS = 20480;
constexpr bool F8P = (MK_FP8 & 1) != 0, F8M = (MK_FP8 & 2) != 0, F8B = (MK_FP8 & 4) != 0, F8D = (MK_FP8 & 8) != 0, F8U = (MK_FP8 & 16) != 0;
constexpr float S_C = 16.f;
constexpr float S_YA = 2.f, S_YB = 32.f, S_YC = 16.f, S_Y = 16.f, S_HID = 16.f;
#ifndef MK_PV8
#define MK_PV8 7
#endif
constexpr bool PV8A = (MK_PV8 & 1) != 0, PV8B = (MK_PV8 & 2) != 0, PV8C = (MK_PV8 & 4) != 0;
#ifndef MK_QK8
#define MK_QK8 3
#endif
constexpr bool QK8A = (MK_QK8 & 1) != 0 && PV8A, QK8B = (MK_QK8 & 2) != 0 && PV8B;
constexpr float S_QK = 16.f;
#ifndef MK_GATE8
#define MK_GATE8 1
#endif
constexpr bool GATE8 = MK_GATE8 != 0 && F8B;
constexpr float S_V = 16.f;
constexpr float PV8_LOG2S = 4.5849625f, PV8_SCALE = 24.0f, PV8_THR = 4.0f;
constexpr int HROWB = F8P ? 2048 : 4096, HSROWB = F8M ? 2048 : 4096;

constexpr size_t MiB = 1u << 20;
constexpr size_t WS_CTL = 0, CTL_ZERO_BYTES = 1 * MiB;
constexpr size_t WS_MOD = 1 * MiB, WS_COS = 2 * MiB, WS_SIN = 3 * MiB, WS_ROUTE = 4 * MiB, WS_ROWIDX = 4 * MiB + 256 * 1024, WS_GATEW = 4 * MiB + 512 * 1024,
                 WS_SSQQ = 5 * MiB, WS_SSQK = 5 * MiB + 512 * 1024, WS_RT8 = 5 * MiB + 768 * 1024;
constexpr size_t WS_W = 6 * MiB, W_STRIDE = 165 * MiB;
constexpr size_t WO_WIN = 0, WO_WUQ = 46 * MiB, WO_WUKV = 47 * MiB + 512 * 1024, WO_WABC = 48 * MiB + 512 * 1024, WO_WO = 60 * MiB + 512 * 1024, WO_W13 = 68 * MiB + 512 * 1024,
                 WO_W2 = 132 * MiB + 512 * 1024;
constexpr size_t WS_XCUR = 336 * MiB, WS_H = 400 * MiB, WS_U = 432 * MiB, WS_ARENA = 496 * MiB;
constexpr size_t AR_AQ = 0, AR_AK = 16 * MiB, AR_AV = 32 * MiB, AR_CQ = 48 * MiB, AR_CKV = 56 * MiB, AR_SWQ = 60 * MiB, AR_SWK = 76 * MiB, AR_SWV = 80 * MiB, AR_GATES = 84 * MiB,
                 AR_QM = 180 * MiB, AR_KM = 204 * MiB, AR_VM = 228 * MiB, AR_YABC = 244 * MiB, AR_Y = 292 * MiB, AR_SCR = 324 * MiB, AR_END = 356 * MiB;
constexpr size_t AR_HS = 0, AR_HID = 80 * MiB, AR_OS = 100 * MiB;
constexpr size_t WS_END = WS_ARENA + AR_END;
constexpr int CW_BAR = 4096, CW_CNT = 16384;

constexpr int RING_BYTES = 131072, LDSCTL_OFF = 139264, LDS_BYTES = 147456;
constexpr int L_MISC = LDSCTL_OFF;
constexpr int L_BASE = LDSCTL_OFF + 256;
constexpr int L_TILEEXP = LDSCTL_OFF + 512;
constexpr int L_ROWTOK = RING_BYTES;
constexpr int L_ROWGW = RING_BYTES + 2048;

typedef float f32x2_cv __attribute__((ext_vector_type(2))); typedef __bf16 bf16x2_cv __attribute__((ext_vector_type(2)));
__device__ __forceinline__ unsigned cvt_pk_bf16(float lo, float hi) { const f32x2_cv v = {lo, hi}; const bf16x2_cv b = __builtin_convertvector(v, bf16x2_cv); return __builtin_bit_cast(unsigned, b); }
__device__ __forceinline__ u32x2 pk_bf4(f32x4 v) { u32x2 w; w.x = cvt_pk_bf16(v[0], v[1]); w.y = cvt_pk_bf16(v[2], v[3]); return w; }
__device__ __forceinline__ unsigned pack4_fp8(float a, float b, float c, float d) { int w = 0; w = __builtin_amdgcn_cvt_pk_fp8_f32(a, b, w, false); w = __builtin_amdgcn_cvt_pk_fp8_f32(c, d, w, true); return (unsigned)w; }
__device__ __forceinline__ float clamp8(float x) { return __builtin_amdgcn_fmed3f(x, -448.f, 448.f); }
__device__ __forceinline__ unsigned pack4_fp8s(float a, float b, float c, float d, float s) { return pack4_fp8(clamp8(a * s), clamp8(b * s), clamp8(c * s), clamp8(d * s)); }
__device__ __forceinline__ unsigned char fp8_byte(float x) { return (unsigned char)((unsigned)__builtin_amdgcn_cvt_pk_fp8_f32(clamp8(x), 0.f, 0, false) & 0xffu); }
__device__ __forceinline__ unsigned pack4_u8(float a, float b, float c, float d) { unsigned w = 0; w = __builtin_amdgcn_cvt_pk_u8_f32(a, 0, w); w = __builtin_amdgcn_cvt_pk_u8_f32(b, 1, w); w = __builtin_amdgcn_cvt_pk_u8_f32(c, 2, w); w = __builtin_amdgcn_cvt_pk_u8_f32(d, 3, w); return w; }
__device__ __forceinline__ float gate8(float g) { return __builtin_amdgcn_fmed3f(g * 255.0f, 1.0f, 255.0f); }
__device__ __forceinline__ float ub0(unsigned w) { return (float)(w & 0xffu); }
__device__ __forceinline__ float ub1(unsigned w) { return (float)((w >> 8) & 0xffu); }
__device__ __forceinline__ float ub2(unsigned w) { return (float)((w >> 16) & 0xffu); }
__device__ __forceinline__ float ub3(unsigned w) { return (float)(w >> 24); }
__device__ __forceinline__ f32x4 ld_bf4(const void* p) { const u32x2 w = *(const u32x2*)p; f32x4 r; r[0] = __uint_as_float(w.x << 16); r[1] = __uint_as_float(w.x & 0xffff0000u); r[2] = __uint_as_float(w.y << 16); r[3] = __uint_as_float(w.y & 0xffff0000u); return r; }
__device__ __forceinline__ f32x4 up_bf4(u32x2 w) { f32x4 r; r[0] = __uint_as_float(w.x << 16); r[1] = __uint_as_float(w.x & 0xffff0000u); r[2] = __uint_as_float(w.y << 16); r[3] = __uint_as_float(w.y & 0xffff0000u); return r; }
__device__ __forceinline__ float bf2f(unsigned short b) { return __uint_as_float(((unsigned)b) << 16); }
__device__ __forceinline__ float bflo(unsigned w) { return __uint_as_float(w << 16); }
__device__ __forceinline__ float bfhi(unsigned w) { return __uint_as_float(w & 0xffff0000u); }
__device__ __forceinline__ float xor16_sum(float x) { auto r = __builtin_amdgcn_permlane16_swap(__float_as_uint(x), __float_as_uint(x), false, false); return __uint_as_float(r[0]) + __uint_as_float(r[1]); }
__device__ __forceinline__ float xor32_sum(float x) { auto r = __builtin_amdgcn_permlane32_swap(__float_as_uint(x), __float_as_uint(x), false, false); return __uint_as_float(r[0]) + __uint_as_float(r[1]); }
template <int CTRL> __device__ __forceinline__ float dpp_f(float x) { return __int_as_float(__builtin_amdgcn_update_dpp(0, __float_as_int(x), CTRL, 0xF, 0xF, false)); }
__device__ __forceinline__ float row16_sum(float v) { v += dpp_f<0xB1>(v); v += dpp_f<0x4E>(v); v += dpp_f<0x141>(v); v += dpp_f<0x140>(v); return v; }
#ifndef MK_SHFL_SUM
#define MK_SHFL_SUM 0
#endif
#if MK_SHFL_SUM
__device__ __forceinline__ float wave_sum(float v) {
#pragma unroll
    for (int o = 1; o < 64; o <<= 1) v += __shfl_xor(v, o);
    return v;
}
#else
__device__ __forceinline__ float wave_sum(float v) { return xor32_sum(xor16_sum(row16_sum(v))); }
#endif
__device__ __forceinline__ float sigmoidf_(float x) { return __builtin_amdgcn_rcpf(1.0f + __builtin_amdgcn_exp2f(-1.4426950408889634f * x)); }
__device__ __forceinline__ int opaque_lane() { int t; asm volatile("v_mbcnt_lo_u32_b32 %0, -1, 0\n\tv_mbcnt_hi_u32_b32 %0, -1, %0" : "=v"(t)); return t; }
__device__ __forceinline__ int opaque_tid(int wv) { return opaque_lane() + wv * 64; }
template <class Tp> __device__ __forceinline__ GAS Tp* opaque_ptr(Tp* p) { GAS Tp* g = (GAS Tp*)p; asm volatile("" : "+v"(g)); return g; }
#define LDS_WAIT() asm volatile("s_waitcnt lgkmcnt(0)" ::: "memory")
#define VM_WAIT() asm volatile("s_waitcnt vmcnt(0)" ::: "memory")

#define XB_TMO      128
#define XB_XCNT(j)  (256  + 64 * (j))
#define XB_XSUB(j)  (1280 + 64 * (j))
#define XB_XGEN(j)  (2304 + 64 * (j))
#define XB_TOP      3328
#define XB_TOPGEN   3392
#define XCD_BAR_WORDS 3456
#define XB_SPIN_CAP (1u << 18)
__device__ __forceinline__ unsigned xb_ld(unsigned* p)              { return __hip_atomic_load(p, __ATOMIC_RELAXED, __HIP_MEMORY_SCOPE_AGENT); }
__device__ __forceinline__ unsigned xb_add(unsigned* p, unsigned v) { return __hip_atomic_fetch_add(p, v, __ATOMIC_RELAXED, __HIP_MEMORY_SCOPE_AGENT); }
__device__ __forceinline__ unsigned xb_xcc_id() { return (unsigned)__builtin_amdgcn_s_getreg((3 << 11) | 20) & 0xFu; }
#define XB_SPIN(cond, bar) do { unsigned _sp = 0; while (cond) { __builtin_amdgcn_s_sleep(1); \
    if ((++_sp & 255u) == 0u) { if (xb_ld(&(bar)[XB_TMO])) break; if (_sp > XB_SPIN_CAP) { atomicAdd(&(bar)[XB_TMO], 1u); break; } } } } while (0)
struct XcdBarrier { unsigned* bar; unsigned x; volatile LAS unsigned* st; };
__device__ __forceinline__ XcdBarrier xcd_barrier_post(unsigned* bar, volatile LAS unsigned* st) {
    XcdBarrier b; b.bar = bar; b.x = xb_xcc_id(); b.st = st;
    if (threadIdx.x == 0) (void)xb_add(&bar[XB_XCNT(b.x)], 1u);
    return b;
}
__device__ __forceinline__ void xcd_barrier_complete(unsigned* bar, unsigned x, unsigned& nloc, unsigned& nx) {
    const unsigned G = gridDim.x * gridDim.y * gridDim.z;
    unsigned sum, cnt, mine, sp = 0u;
    for (;;) {
        sum = 0u; cnt = 0u; mine = 0u;
#pragma unroll
        for (unsigned j = 0; j < 16; ++j) { const unsigned c = xb_ld(&bar[XB_XCNT(j)]); sum += c; cnt += (c > 0u) ? 1u : 0u; mine = (j == x) ? c : mine; }
        if (sum == G) break;
        __builtin_amdgcn_s_sleep(1);
        if ((++sp & 255u) == 0u) { if (xb_ld(&bar[XB_TMO])) break; if (sp > XB_SPIN_CAP) { atomicAdd(&bar[XB_TMO], 1u); break; } }
    }
    nloc = mine > 0u ? mine : 1u; nx = cnt > 0u ? cnt : 1u;
}
__device__ __forceinline__ void xcd_barrier(const XcdBarrier& b) {
    asm volatile("s_waitcnt vmcnt(0)" ::: "memory");
    __syncthreads();
    if (threadIdx.x == 0) {
        unsigned* bar = b.bar;
        __builtin_amdgcn_s_waitcnt(0);
        unsigned nloc = b.st[0], nx = b.st[1];
        if (nloc == 0u) { xcd_barrier_complete(bar, b.x, nloc, nx); b.st[0] = nloc; b.st[1] = nx; }
        const unsigned old = xb_add(&bar[XB_XSUB(b.x)], 1u);
        const unsigned gen = old / nloc;
        if (old + 1u == (gen + 1u) * nloc) {
            __builtin_amdgcn_fence(__ATOMIC_RELEASE, "agent");
            asm volatile("s_waitcnt vmcnt(0)" ::: "memory");
            const unsigned og = xb_add(&bar[XB_TOP], 1u);
            const unsigned tg = og / nx;
            if (og + 1u == (tg + 1u) * nx) xb_add(&bar[XB_TOPGEN], 1u);
            else XB_SPIN(xb_ld(&bar[XB_TOPGEN]) == tg, bar);
            __builtin_amdgcn_fence(__ATOMIC_ACQUIRE, "agent");
            xb_add(&bar[XB_XGEN(b.x)], 1u);
            asm volatile("s_waitcnt vmcnt(0)" ::: "memory");
        } else {
            XB_SPIN(xb_ld(&bar[XB_XGEN(b.x)]) == gen, bar);
            __builtin_amdgcn_fence(__ATOMIC_ACQUIRE, "agent");
            asm volatile("s_waitcnt vmcnt(0)" ::: "memory");
        }
    }
    __syncthreads();
}

namespace pg8 {
constexpr int BM = 256, BK = 64, HALF = 128, HTB = HALF * BK * 2, STAGE_BYTES = 8 * HTB, NXCD = 8, WGM = 8;
__host__ __device__ __forceinline__ int lds_byte(int r, int c) { const int st = (r >> 4) * 2 + (c >> 5), rr = r & 15, cc = c & 31, ob = rr * 64 + cc * 2; return st * 1024 + (ob ^ (((ob >> 9) & 1) << 5)); }
__host__ __device__ __forceinline__ void stage_rc(int b, int& R, int& C) { const int st = b / 1024, sb = b % 1024, swz = sb ^ (((sb >> 9) & 1) << 5); R = (st >> 1) * 16 + swz / 64; C = (st & 1) * 32 + (swz % 64) / 2; }
__host__ __device__ __forceinline__ int perm32(int rho) { const int n = rho >> 4, i = rho & 15; return 8 * (i >> 2) + 4 * n + (i & 3); }

struct Unit { int pm, pn, arow, brow, aux; };
struct Gemm { const bf16_t* A; const bf16_t* Bt; int K; float rs = 0.015625f; };

struct StaticOrder {
    int nM, nN, nwg, G, c;
    __device__ void init(int M, int N, int G_, int c_) { nM = M / BM; nN = N / BM; nwg = nM * nN; G = G_; c = c_; }
    __device__ bool tile(long L, Unit& u) const {
        int wgid = (int)L; { const int q = nwg / NXCD, r = nwg % NXCD, xcd = wgid % NXCD, off = wgid / NXCD; wgid = (xcd < r ? xcd * (q + 1) : r * (q + 1) + (xcd - r) * q) + off; }
        const int nig = WGM * nN, gid = wgid / nig, fm = gid * WGM, gsz = (nM - fm) < WGM ? (nM - fm) : WGM;
        u.pm = fm + ((wgid % nig) % gsz); u.pn = (wgid % nig) / gsz; return true;
    }
    __device__ bool next(int i, Unit& u) const {
        const long L = (long)i * G + c; if (L >= nwg) return false;
        tile(L, u); u.arow = u.pm * BM; u.brow = u.pn * BM; u.aux = 0; return true;
    }
};
struct BranchOrder : StaticOrder {
    int rowsA, rowsB;
    __device__ bool next(int i, Unit& u) const {
        if (i >= 3 || c >= nwg) return false;
        tile(c, u); u.arow = i * rowsA + u.pm * BM; u.brow = i * rowsB + u.pn * BM; u.aux = i; return true;
    }
};
struct GroupedOrder {
    const LAS int* tab; int nrt, npn, G, c, nbrows;
    __device__ bool next(int i, Unit& u) const {
        const int L = i * G + c; if (L >= nrt * npn) return false;
        u.pm = L / npn; u.pn = L % npn; const int e = __builtin_amdgcn_readfirstlane(tab[u.pm]); u.arow = u.pm * BM; u.brow = e * nbrows + u.pn * BM; u.aux = e; return true;
    }
};

struct GroupedGatherOrder : GroupedOrder {
    const LAS int* rowtab;
    __device__ bool next(int i, Unit& u) const { if (!GroupedOrder::next(i, u)) return false; u.aux |= (i & 1) << 8; u.arow = 0; return true; }
};
template <class S> struct sched_gathers { static constexpr bool value = false; };
template <> struct sched_gathers<GroupedGatherOrder> { static constexpr bool value = true; };
typedef int i32x4v __attribute__((ext_vector_type(4)));
typedef int i32x8v __attribute__((ext_vector_type(8)));
typedef int i32x16v __attribute__((ext_vector_type(16)));
typedef int i32x32v __attribute__((ext_vector_type(32)));
__host__ __device__ __forceinline__ void stage_rc8(int b, int& R, int& C) { const int st = b >> 10, rr = (b >> 6) & 15, c4 = ((b >> 4) & 3) ^ ((rr >> 3) & 1); R = (st >> 1) * 16 + rr; C = ((st & 1) * 4 + c4) * 8; }
template <class Epi, class Sched, bool F8 = false, bool ALIGN_EPI = true, bool SP2 = true>
__device__ __forceinline__ void gemm_phase(LAS unsigned char* lds, const Gemm g, const Sched& S, const Epi& E, int wv) {
    const int tid = opaque_tid(wv), wid = __builtin_amdgcn_readfirstlane(tid >> 6), lane = tid & 63, wr = wid >> 2, wc = wid & 3, fr = lane & 15, fq = lane >> 4;
    int K = g.K; asm volatile("" : "+s"(K));
    const int nt = K / BK;
    unsigned voffA[2], voffB[2];
#pragma unroll
    for (int i = 0; i < 2; ++i) { int R, C; if constexpr (F8) stage_rc8(tid * 16 + i * 8192, R, C); else stage_rc(tid * 16 + i * 8192, R, C); const int Rb = Epi::PERM ? ((R & ~31) + perm32(R & 31)) : R;
        voffA[i] = (unsigned)(R * K + C) * 2u; voffB[i] = (unsigned)(Rb * K + C) * 2u; }
    constexpr bool GATHER = sched_gathers<Sched>::value;
    const unsigned kstep = (unsigned)(BK * 2);
    const unsigned hstep = (unsigned)HALF * (unsigned)K * 2u;
    const unsigned hstepA = GATHER ? 0u : hstep;
    unsigned gcur[2][2]; int uin = 0;
#define PG8_GLOAD(dst, ui_) do { if constexpr (GATHER) { const LAS int* rt_ = S.rowtab + ((ui_) & 1) * 256; _Pragma("unroll") for (int h_ = 0; h_ < 2; ++h_) _Pragma("unroll") for (int i_ = 0; i_ < 2; ++i_) { \
        int R_, C_; stage_rc8(tid * 16 + i_ * 8192, R_, C_); dst[h_][i_] = (unsigned)rt_[R_ + HALF * h_] * (unsigned)K * 2u + (unsigned)C_ * 2u; } } } while (0)
#define PG8_STAGE_A(bufoff, soff, h, nx) do { if constexpr (GATHER) { unsigned vo_[2] = {gcur[h][0], gcur[h][1]}; \
        if (nx) { const LAS int* rt_ = S.rowtab + (uin & 1) * 256; _Pragma("unroll") for (int i_ = 0; i_ < 2; ++i_) { int R_, C_; stage_rc8(tid * 16 + i_ * 8192, R_, C_); vo_[i_] = (unsigned)rt_[R_ + HALF * (h)] * (unsigned)K * 2u + (unsigned)C_ * 2u; } } \
        PG8_STAGE(bufoff, rsA, soff, vo_); } else PG8_STAGE(bufoff, rsA, soff, voffA); } while (0)
    const unsigned rstep = (unsigned)K * 2u;
    const unsigned ldsw = (unsigned)wid * 1024u;
    const int x8 = (fr >> 3) & 1;
    const int f8base = (fq >> 1) * 1024 + fr * 64 + (fq & 1) * 32;
    const int aoff = F8 ? (wr * 8) * 1024 + f8base + 16 * x8 : lds_byte(wr * 64 + fr, fq * 8), boff = F8 ? (wc * 4) * 1024 + f8base + 16 * x8 : lds_byte(wc * 32 + fr, fq * 8);
    const int aoff1 = F8 ? (wr * 8) * 1024 + f8base + 16 - 16 * x8 : 0, boff1 = F8 ? (wc * 4) * 1024 + f8base + 16 - 16 * x8 : 0;
    constexpr int KOFF = 1024;
    const __amdgpu_buffer_rsrc_t rsA = __builtin_amdgcn_make_buffer_rsrc((void*)g.A, (short)0, 0xFFFFFFFF, 0x00020000);
    const __amdgpu_buffer_rsrc_t rsB = __builtin_amdgcn_make_buffer_rsrc((void*)g.Bt, (short)0, 0xFFFFFFFF, 0x00020000);
#define PG8_SA(b, h) (((b) * 2 + (h)) * HTB)
#define PG8_SB(b, h) ((4 + (b) * 2 + (h)) * HTB)
#define PG8_STAGE(bufoff, rs, soff, voff) do { _Pragma("unroll") for (int _i = 0; _i < 2; ++_i) \
        __builtin_amdgcn_raw_ptr_buffer_load_lds(rs, (LAS unsigned*)(lds + (bufoff) + ldsw + _i * 8192), 16, (voff)[_i], (soff), 0, 0); } while (0)
#define PG8_LD16(off) (*(const LAS i32x4v*)(lds + (off)))
#define PG8_LDA(dst, b, h) do { _Pragma("unroll") for (int m = 0; m < 4; ++m) { if constexpr (F8) dst##8[m] = __builtin_shufflevector(PG8_LD16(PG8_SA(b, h) + aoff + m * 2048), PG8_LD16(PG8_SA(b, h) + aoff1 + m * 2048), 0, 1, 2, 3, 4, 5, 6, 7); \
        else { _Pragma("unroll") for (int k = 0; k < 2; ++k) dst[m][k] = *(const LAS bf16x8*)(lds + PG8_SA(b, h) + aoff + m * 2048 + k * KOFF); } } } while (0)
#define PG8_LDB(dst, b, h) do { _Pragma("unroll") for (int n = 0; n < 2; ++n) { if constexpr (F8) dst##8[n] = __builtin_shufflevector(PG8_LD16(PG8_SB(b, h) + boff + n * 2048), PG8_LD16(PG8_SB(b, h) + boff1 + n * 2048), 0, 1, 2, 3, 4, 5, 6, 7); \
        else { _Pragma("unroll") for (int k = 0; k < 2; ++k) dst[n][k] = *(const LAS bf16x8*)(lds + PG8_SB(b, h) + boff + n * 2048 + k * KOFF); } } } while (0)
#define PG8_PIN(ai, bj) asm volatile("" : "+v"(acc[ai][bj][0][0]), "+v"(acc[ai][bj][0][1]), "+v"(acc[ai][bj][1][0]), "+v"(acc[ai][bj][1][1]), "+v"(acc[ai][bj][2][0]), "+v"(acc[ai][bj][2][1]), "+v"(acc[ai][bj][3][0]), "+v"(acc[ai][bj][3][1]))
#define PG8_MMA(ai, bj, At, Bt) do { __builtin_amdgcn_s_setprio(1); \
        if constexpr (F8) { PG8_PIN(ai, bj); _Pragma("unroll") for (int m = 0; m < 4; ++m) _Pragma("unroll") for (int n = 0; n < 2; ++n) { \
            if (MK_F8_NOSCALE) { _Pragma("unroll") for (int q = 0; q < 4; ++q) acc[ai][bj][m][n] = __builtin_amdgcn_mfma_f32_16x16x32_fp8_fp8( \
                (long)(((unsigned long long)(unsigned)Bt##8[n][2 * q + 1] << 32) | (unsigned)Bt##8[n][2 * q]), (long)(((unsigned long long)(unsigned)At##8[m][2 * q + 1] << 32) | (unsigned)At##8[m][2 * q]), acc[ai][bj][m][n], 0, 0, 0); } \
            else acc[ai][bj][m][n] = __builtin_amdgcn_mfma_scale_f32_16x16x128_f8f6f4(Bt##8[n], At##8[m], acc[ai][bj][m][n], 0, 0, 0, 0, 0, 0); }     PG8_PIN(ai, bj); } \
        else { _Pragma("unroll") for (int m = 0; m < 4; ++m) _Pragma("unroll") for (int n = 0; n < 2; ++n) _Pragma("unroll") for (int k = 0; k < 2; ++k) \
            acc[ai][bj][m][n] = __builtin_amdgcn_mfma_f32_16x16x32_bf16(Bt[n][k], At[m][k], acc[ai][bj][m][n], 0, 0, 0); } \
        __builtin_amdgcn_s_setprio(0); } while (0)
#define PG8_WAIT_V(n) asm volatile("s_waitcnt vmcnt(" #n ")" ::: "memory")
#define PG8_WAIT_L(n) asm volatile("s_waitcnt lgkmcnt(" #n ")" ::: "memory")
#define PG8_BAR __builtin_amdgcn_s_barrier()
#define PG8_SCHED __builtin_amdgcn_sched_barrier(0)
    Unit cur, nxt; int ui = 0;
    if (!S.next(0, cur)) return;
    f32x4 acc[2][2][4][2];
#pragma unroll
    for (int a = 0; a < 2; ++a)
#pragma unroll
        for (int b = 0; b < 2; ++b)
#pragma unroll
            for (int m = 0; m < 4; ++m)
#pragma unroll
                for (int n = 0; n < 2; ++n) acc[a][b][m][n] = (f32x4){0.f, 0.f, 0.f, 0.f};
    bf16x8 At[4][2], B0[2][2], B1[2][2];
    i32x8v At8[4], B08[2], B18[2];
    unsigned cA = (unsigned)cur.arow * rstep, cB = (unsigned)cur.brow * rstep;
    PG8_GLOAD(gcur, 0);
    if constexpr (SP2) {
        PG8_STAGE(PG8_SB(0, 0), rsB, cB, voffB); PG8_STAGE(PG8_SB(0, 1), rsB, cB + hstep, voffB); PG8_STAGE_A(PG8_SA(0, 0), cA, 0, false); PG8_STAGE_A(PG8_SA(0, 1), cA + hstepA, 1, false);
        if (wr == 1) PG8_BAR;
        PG8_WAIT_V(2); PG8_BAR;
        PG8_STAGE(PG8_SB(1, 0), rsB, cB + kstep, voffB); PG8_STAGE_A(PG8_SA(1, 0), cA + kstep, 0, false); PG8_STAGE(PG8_SB(1, 1), rsB, cB + hstep + kstep, voffB);
        PG8_WAIT_V(6); PG8_BAR;
    } else {
        PG8_STAGE(PG8_SB(0, 0), rsB, cB, voffB); PG8_STAGE_A(PG8_SA(0, 0), cA, 0, false); PG8_STAGE(PG8_SB(0, 1), rsB, cB + hstep, voffB); PG8_STAGE_A(PG8_SA(0, 1), cA + hstepA, 1, false);
        if (wr == 1) PG8_BAR;
        PG8_WAIT_V(4); PG8_BAR;
        PG8_STAGE(PG8_SB(1, 0), rsB, cB + kstep, voffB); PG8_STAGE_A(PG8_SA(1, 0), cA + kstep, 0, false); PG8_STAGE(PG8_SB(1, 1), rsB, cB + hstep + kstep, voffB);
        PG8_WAIT_V(6); PG8_BAR;
    }
    for (;;) {
        const bool has_next = S.next(ui + 1, nxt);
        const unsigned nA = has_next ? (unsigned)nxt.arow * rstep : cA, nB = has_next ? (unsigned)nxt.brow * rstep : cB;
        if constexpr (GATHER) uin = has_next ? ui + 1 : ui;
        for (int t = 0; t < nt; t += 2) {
            if constexpr (Epi::MIDSCALE) { if (t == 8 || t == 16) { const int ln_ = opaque_lane(); E.mid(acc, cur, t >> 3, wr, wc, ln_ & 15, ln_ >> 4); } }
            const bool last = (t == nt - 2);
            const unsigned a1 = cA + (unsigned)(t + 1) * kstep;
            const unsigned a2 = last ? nA : cA + (unsigned)(t + 2) * kstep, b2 = last ? nB : cB + (unsigned)(t + 2) * kstep;
            const unsigned a3 = a2 + kstep, b3 = b2 + kstep;
            if constexpr (SP2) {
            PG8_LDB(B0, 0, 0); PG8_LDB(B1, 0, 1); PG8_SCHED; PG8_LDA(At, 0, 0); PG8_STAGE_A(PG8_SA(1, 1), a1 + hstepA, 1, false);
            PG8_WAIT_V(8); PG8_WAIT_L(0); PG8_BAR; PG8_MMA(0, 0, At, B0); PG8_MMA(0, 1, At, B1); PG8_BAR; PG8_SCHED;
            PG8_LDA(At, 0, 1); PG8_STAGE(PG8_SB(0, 0), rsB, b2, voffB); PG8_STAGE(PG8_SB(0, 1), rsB, b2 + hstep, voffB); PG8_STAGE_A(PG8_SA(0, 0), a2, 0, last);
            PG8_WAIT_V(8); PG8_WAIT_L(0); PG8_BAR; PG8_MMA(1, 0, At, B0); PG8_MMA(1, 1, At, B1); PG8_BAR; PG8_SCHED;
            PG8_LDB(B0, 1, 0); PG8_LDB(B1, 1, 1); PG8_SCHED; PG8_LDA(At, 1, 0); PG8_STAGE_A(PG8_SA(0, 1), a2 + hstepA, 1, last);
            PG8_WAIT_V(8); PG8_WAIT_L(0); PG8_BAR; PG8_MMA(0, 0, At, B0); PG8_MMA(0, 1, At, B1); PG8_BAR; PG8_SCHED;
            PG8_LDA(At, 1, 1); PG8_STAGE(PG8_SB(1, 0), rsB, b3, voffB); PG8_STAGE(PG8_SB(1, 1), rsB, b3 + hstep, voffB); PG8_STAGE_A(PG8_SA(1, 0), a3, 0, last);
            PG8_WAIT_V(8); PG8_WAIT_L(0); PG8_BAR; PG8_MMA(1, 0, At, B0); PG8_MMA(1, 1, At, B1); PG8_BAR; PG8_SCHED;
            } else {
            PG8_LDB(B0, 0, 0); PG8_SCHED; PG8_LDA(At, 0, 0); PG8_STAGE_A(PG8_SA(1, 1), a1 + hstepA, 1, false);
            PG8_WAIT_L(8); PG8_BAR; PG8_WAIT_L(0); PG8_MMA(0, 0, At, B0); PG8_BAR; PG8_SCHED;
            PG8_LDB(B1, 0, 1); PG8_STAGE(PG8_SB(0, 0), rsB, b2, voffB);
            PG8_BAR; PG8_WAIT_L(0); PG8_MMA(0, 1, At, B1); PG8_BAR;
            PG8_LDA(At, 0, 1); PG8_STAGE_A(PG8_SA(0, 0), a2, 0, last);
            PG8_BAR; PG8_WAIT_L(0); PG8_MMA(1, 0, At, B0); PG8_BAR; PG8_SCHED;
            PG8_STAGE(PG8_SB(0, 1), rsB, b2 + hstep, voffB);
            PG8_WAIT_V(6); PG8_BAR; PG8_MMA(1, 1, At, B1); PG8_BAR;
            PG8_LDB(B0, 1, 0); PG8_SCHED; PG8_LDA(At, 1, 0); PG8_STAGE_A(PG8_SA(0, 1), a2 + hstepA, 1, last);
            PG8_WAIT_L(8); PG8_BAR; PG8_WAIT_L(0); PG8_MMA(0, 0, At, B0); PG8_BAR; PG8_SCHED;
            PG8_LDB(B1, 1, 1); PG8_STAGE(PG8_SB(1, 0), rsB, b3, voffB);
            PG8_BAR; PG8_WAIT_L(0); PG8_MMA(0, 1, At, B1); PG8_BAR;
            PG8_LDA(At, 1, 1); PG8_STAGE_A(PG8_SA(1, 0), a3, 0, last);
            PG8_BAR; PG8_WAIT_L(0); PG8_MMA(1, 0, At, B0); PG8_BAR; PG8_SCHED;
            PG8_STAGE(PG8_SB(1, 1), rsB, b3 + hstep, voffB);
            PG8_WAIT_V(6); PG8_BAR; PG8_MMA(1, 1, At, B1); PG8_BAR;
            }
        }
        if constexpr (ALIGN_EPI) { if (wr == 0) PG8_BAR; }
        if constexpr (F8) { const float rs_ = g.rs * E.unit_scale(cur);
#pragma unroll
            for (int a = 0; a < 2; ++a)
#pragma unroll
                for (int b = 0; b < 2; ++b)
#pragma unroll
                    for (int m = 0; m < 4; ++m)
#pragma unroll
                        for (int n = 0; n < 2; ++n) acc[a][b][m][n] = acc[a][b][m][n] * rs_; }
        { const int t_ = opaque_lane();
          E(acc, cur, wr, wc, t_ & 15, (t_ >> 4) & 3); }
        if (!has_next) break;
#pragma unroll
        for (int a = 0; a < 2; ++a)
#pragma unroll
            for (int b = 0; b < 2; ++b)
#pragma unroll
                for (int m = 0; m < 4; ++m)
#pragma unroll
                    for (int n = 0; n < 2; ++n) acc[a][b][m][n] = (f32x4){0.f, 0.f, 0.f, 0.f};
        cur = nxt; cA = nA; cB = nB; ++ui;
        PG8_GLOAD(gcur, ui);
        if constexpr (ALIGN_EPI) { if (wr == 1) PG8_BAR; }
    }
    PG8_WAIT_V(0);
    if constexpr (!ALIGN_EPI) { if (wr == 0) PG8_BAR; }
    PG8_BAR;
#undef PG8_SA
#undef PG8_GLOAD
#undef PG8_STAGE_A
#undef PG8_SB
#undef PG8_STAGE
#undef PG8_LDA
#undef PG8_LDB
#undef PG8_MMA
#undef PG8_PIN
#undef PG8_LD16
#undef PG8_WAIT_V
#undef PG8_WAIT_L
#undef PG8_BAR
#undef PG8_SCHED
}

__device__ __forceinline__ u32x4 pack8(f32x4 a, f32x4 b) { u32x4 w; w.x = cvt_pk_bf16(a[0], a[1]); w.y = cvt_pk_bf16(a[2], a[3]); w.z = cvt_pk_bf16(b[0], b[1]); w.w = cvt_pk_bf16(b[2], b[3]); return w; }
__device__ __forceinline__ void store_vt8(const f32x4 (&acc)[2][2][4][2], const Unit& u, int wr, int wc, int fr, int fq, unsigned char* VT, int hb, const float (&rs)[2][4], int rb0 = -1, int rb1 = -1) {
    const unsigned selA = (fr & 1) ? 0x07030501u : 0x02060004u, selB = (fr & 2) ? 0x07060302u : 0x01000504u;
    const int a4 = fr >> 2, iq = fr & 3, s64 = (u.pm * BM + wr * 64) & 4095;
#pragma unroll
    for (int ai = 0; ai < 2; ++ai)
#pragma unroll
        for (int m = 0; m < 4; ++m) { const int slot4 = (a4 & 1) * 32 + (m >> 1) * 16 + ((m & 1) * 2 + (a4 >> 1)) * 4; const float sc = rs[ai][m] * S_V;
#pragma unroll
            for (int bj = 0; bj < 2; ++bj) {
                unsigned w0 = pack4_fp8s(acc[ai][bj][m][0][0], acc[ai][bj][m][0][1], acc[ai][bj][m][0][2], acc[ai][bj][m][0][3], sc);
                unsigned w1 = pack4_fp8s(acc[ai][bj][m][1][0], acc[ai][bj][m][1][1], acc[ai][bj][m][1][2], acc[ai][bj][m][1][3], sc);
                { const unsigned p0 = (unsigned)__builtin_amdgcn_update_dpp(0, (int)w0, 0xB1, 0xF, 0xF, false), p1 = (unsigned)__builtin_amdgcn_update_dpp(0, (int)w1, 0xB1, 0xF, 0xF, false);
                  w0 = __builtin_amdgcn_perm(w0, p0, selA); w1 = __builtin_amdgcn_perm(w1, p1, selA); }
                { const unsigned p0 = (unsigned)__builtin_amdgcn_update_dpp(0, (int)w0, 0x4E, 0xF, 0xF, false), p1 = (unsigned)__builtin_amdgcn_update_dpp(0, (int)w1, 0x4E, 0xF, 0xF, false);
                  w0 = __builtin_amdgcn_perm(w0, p0, selB); w1 = __builtin_amdgcn_perm(w1, p1, selB); }
                const int vrow = (rb0 >= 0) ? ((bj ? rb1 : rb0) + iq) : ((hb + bj) * 128 + wc * 32 + 8 * fq + iq);
                unsigned char* d = VT + (size_t)vrow * 4096 + ((s64 + ai * HALF) & 4095) + slot4;
                *(unsigned*)d = w0; *(unsigned*)(d + 4 * 4096) = w1; } }
}
__device__ __forceinline__ void rope_pair_r(const f32x4 (&acc)[2][2][4][2], int ai, int m, f32x4 c0, f32x4 c1, f32x4 s0, f32x4 s1, float mul, u32x4& w1, u32x4& w2) {
    const f32x4 a0 = acc[ai][0][m][0] * mul, a1 = acc[ai][0][m][1] * mul, b0 = acc[ai][1][m][0] * mul, b1 = acc[ai][1][m][1] * mul;
    w1 = pack8(a0 * c0 - b0 * s0, a1 * c1 - b1 * s1);
    w2 = pack8(b0 * c0 + a0 * s0, b1 * c1 + a1 * s1);
}
__device__ __forceinline__ void rope_pair(const f32x4 (&acc)[2][2][4][2], int ai, int m, const float* cs, const float* sn, float mul, u32x4& w1, u32x4& w2) {
    const f32x4 c0 = *(const f32x4*)cs, c1 = *(const f32x4*)(cs + 4), s0 = *(const f32x4*)sn, s1 = *(const f32x4*)(sn + 4);
    const f32x4 a0 = acc[ai][0][m][0] * mul, a1 = acc[ai][0][m][1] * mul, b0 = acc[ai][1][m][0] * mul, b1 = acc[ai][1][m][1] * mul;
    w1 = pack8(a0 * c0 - b0 * s0, a1 * c1 - b1 * s1);
    w2 = pack8(b0 * c0 + a0 * s0, b1 * c1 + a1 * s1);
}

struct EpiProj {
    static constexpr bool PERM = true;
    static constexpr bool MIDSCALE = false;
    __device__ __forceinline__ float unit_scale(const Unit&) const { return 1.0f; }
    bf16_t *AQ, *AK, *AV, *CQ, *CKV, *SWQ, *SWK, *SWV, *GATES, *KM; float *SSQQ, *SSQK; const float *COS, *SIN;
    __device__ __forceinline__ void operator()(const f32x4 (&acc)[2][2][4][2], const Unit& u, int wr, int wc, int fr, int fq) const {
        const int pn = u.pn, row0 = u.pm * BM + wr * 64 + fr;
        if (pn < 8 || (pn >= 15 && pn <= 19)) {
            bf16_t* buf; int hb, nh;
            if (pn < 4) { buf = AQ; nh = 16; hb = pn * 4 + wc; } else if (pn < 8) { buf = AK; nh = 16; hb = (pn - 4) * 4 + wc; }
            else if (pn < 19) { buf = SWQ; nh = 16; hb = (pn - 15) * 4 + wc; } else { buf = SWK; nh = 4; hb = wc; }
            f32x4 cs[2][4];
            { const int t = row0; cs[0][0] = *(const f32x4*)(COS + (size_t)t * 32 + 8 * fq); cs[0][1] = *(const f32x4*)(COS + (size_t)t * 32 + 8 * fq + 4); cs[0][2] = *(const f32x4*)(SIN + (size_t)t * 32 + 8 * fq); cs[0][3] = *(const f32x4*)(SIN + (size_t)t * 32 + 8 * fq + 4); }
            asm volatile("" ::: "memory");
#pragma unroll
            for (int ai = 0; ai < 2; ++ai)
#pragma unroll
                for (int m = 0; m < 4; ++m) { const int k = ai * 4 + m, t = row0 + ai * HALF + m * 16, b = t >> 12, s = t & 4095;
                    if (k + 1 < 8) { const int tn = row0 + ((k + 1) >> 2) * HALF + ((k + 1) & 3) * 16;
                        cs[(k + 1) & 1][0] = *(const f32x4*)(COS + (size_t)tn * 32 + 8 * fq); cs[(k + 1) & 1][1] = *(const f32x4*)(COS + (size_t)tn * 32 + 8 * fq + 4);
                        cs[(k + 1) & 1][2] = *(const f32x4*)(SIN + (size_t)tn * 32 + 8 * fq); cs[(k + 1) & 1][3] = *(const f32x4*)(SIN + (size_t)tn * 32 + 8 * fq + 4); asm volatile("" ::: "memory"); }
                    if ((QK8A && pn < 8) || (PV8C && pn >= 15)) {
                        const f32x4 c0 = cs[k & 1][0], c1 = cs[k & 1][1], s0 = cs[k & 1][2], s1 = cs[k & 1][3], a0 = acc[ai][0][m][0], a1 = acc[ai][0][m][1], b0 = acc[ai][1][m][0], b1 = acc[ai][1][m][1];
                        const f32x4 x0 = a0 * c0 - b0 * s0, x1 = a1 * c1 - b1 * s1, y0 = b0 * c0 + a0 * s0, y1 = b1 * c1 + a1 * s1;
                        u32x2 v1, v2; v1.x = pack4_fp8s(x0[0], x0[1], x0[2], x0[3], S_QK); v1.y = pack4_fp8s(x1[0], x1[1], x1[2], x1[3], S_QK); v2.x = pack4_fp8s(y0[0], y0[1], y0[2], y0[3], S_QK); v2.y = pack4_fp8s(y1[0], y1[1], y1[2], y1[3], S_QK);
                        unsigned char* d8 = (unsigned char*)buf + ((size_t)(b * nh + hb) * SEQ + s) * 64 + 8 * fq;
                        *(u32x2*)d8 = v1; *(u32x2*)(d8 + 32) = v2; asm volatile("" ::: "memory");
                    } else {
                    u32x4 w1, w2; rope_pair_r(acc, ai, m, cs[k & 1][0], cs[k & 1][1], cs[k & 1][2], cs[k & 1][3], 1.0f, w1, w2);
                    bf16_t* d = buf + ((size_t)(b * nh + hb) * SEQ + s) * 64 + 8 * fq;
                    *(u32x4*)d = w1; *(u32x4*)(d + 32) = w2; asm volatile("" ::: "memory"); } }
        } else if (pn == 45) {
            if (wc == 0) {
#pragma unroll
                for (int ai = 0; ai < 2; ++ai)
#pragma unroll
                    for (int m = 0; m < 4; ++m) { const int t = row0 + ai * HALF + m * 16, b = t >> 12, s = t & 4095;
                        if (QK8B) { const float* cp = COS + (size_t)t * 32 + 8 * fq; const float* sp = SIN + (size_t)t * 32 + 8 * fq;
                            const f32x4 c0 = *(const f32x4*)cp, c1 = *(const f32x4*)(cp + 4), s0 = *(const f32x4*)sp, s1 = *(const f32x4*)(sp + 4), a0 = acc[ai][0][m][0], a1 = acc[ai][0][m][1], b0 = acc[ai][1][m][0], b1 = acc[ai][1][m][1];
                            const f32x4 x0 = a0 * c0 - b0 * s0, x1 = a1 * c1 - b1 * s1, y0 = b0 * c0 + a0 * s0, y1 = b1 * c1 + a1 * s1;
                            u32x2 v1, v2; v1.x = pack4_fp8s(x0[0], x0[1], x0[2], x0[3], S_QK); v1.y = pack4_fp8s(x1[0], x1[1], x1[2], x1[3], S_QK); v2.x = pack4_fp8s(y0[0], y0[1], y0[2], y0[3], S_QK); v2.y = pack4_fp8s(y1[0], y1[1], y1[2], y1[3], S_QK);
#pragma unroll
                            for (int h = 0; h < 8; ++h) { unsigned char* d8 = (unsigned char*)KM + ((size_t)(b * 8 + h) * SEQ + s) * 192 + 128 + 8 * fq; *(u32x2*)d8 = v1; *(u32x2*)(d8 + 32) = v2; }
                            asm volatile("" ::: "memory"); continue; }
                        u32x4 w1, w2; rope_pair(acc, ai, m, COS + (size_t)t * 32 + 8 * fq, SIN + (size_t)t * 32 + 8 * fq, 1.0f, w1, w2);
#pragma unroll
                        for (int h = 0; h < 8; ++h) { bf16_t* d = KM + ((size_t)(b * 8 + h) * SEQ + s) * 192 + 128 + 8 * fq; *(u32x4*)d = w1; *(u32x4*)(d + 32) = w2; } asm volatile("" ::: "memory"); }
            }
        } else if (pn >= 21) {
            const int col0 = (pn - 21) * BM + wc * 32 + 8 * fq;
#pragma unroll
            for (int ai = 0; ai < 2; ++ai)
#pragma unroll
                for (int m = 0; m < 4; ++m) { const int t = row0 + ai * HALF + m * 16; bf16_t* d = GATES + (size_t)t * 6144 + col0;
#pragma unroll
                    for (int bj = 0; bj < 2; ++bj) { f32x4 v0 = acc[ai][bj][m][0], v1 = acc[ai][bj][m][1];
#pragma unroll
                        for (int j = 0; j < 4; ++j) { v0[j] = sigmoidf_(v0[j]); v1[j] = sigmoidf_(v1[j]); }
                        if (GATE8) { u32x2 o8; o8.x = pack4_u8(gate8(v0[0]), gate8(v0[1]), gate8(v0[2]), gate8(v0[3])); o8.y = pack4_u8(gate8(v1[0]), gate8(v1[1]), gate8(v1[2]), gate8(v1[3]));
                            *(u32x2*)((unsigned char*)GATES + (size_t)t * 6144 + col0 + bj * HALF) = o8; }
                        else *(u32x4*)(d + bj * HALF) = pack8(v0, v1); } }
        } else if (PV8A && pn >= 8 && pn < 12) {
            const float one[2][4] = {{1.f, 1.f, 1.f, 1.f}, {1.f, 1.f, 1.f, 1.f}};
            store_vt8(acc, u, wr, wc, fr, fq, (unsigned char*)AV, ((u.pm * BM) >> 12) * 8 + (pn - 8) * 2, one);
        } else if (pn >= 8 && pn < 12) {
#pragma unroll
            for (int ai = 0; ai < 2; ++ai)
#pragma unroll
                for (int m = 0; m < 4; ++m) { const int t = row0 + ai * HALF + m * 16, b = t >> 12, s = t & 4095;
#pragma unroll
                    for (int bj = 0; bj < 2; ++bj) { bf16_t* d = AV + ((size_t)(b * 8 + (pn - 8) * 2 + bj) * SEQ + s) * 128 + wc * 32 + 8 * fq;
                        *(u32x4*)d = pack8(acc[ai][bj][m][0], acc[ai][bj][m][1]); } }
        } else if (PV8C && pn == 20) {
            const float one[2][4] = {{1.f, 1.f, 1.f, 1.f}, {1.f, 1.f, 1.f, 1.f}}; const int b = (u.pm * BM) >> 12;
            store_vt8(acc, u, wr, wc, fr, fq, (unsigned char*)SWV, 0, one, ((b * 4 + (wc >> 1)) * 64) + (wc & 1) * 32 + 8 * fq, ((b * 4 + 2 + (wc >> 1)) * 64) + (wc & 1) * 32 + 8 * fq);
        } else if (pn == 20) {
#pragma unroll
            for (int ai = 0; ai < 2; ++ai)
#pragma unroll
                for (int m = 0; m < 4; ++m) { const int t = row0 + ai * HALF + m * 16, b = t >> 12, s = t & 4095;
#pragma unroll
                    for (int bj = 0; bj < 2; ++bj) { bf16_t* d = SWV + ((size_t)(b * 4 + 2 * bj + (wc >> 1)) * SEQ + s) * 64 + (wc & 1) * 32 + 8 * fq;
                        *(u32x4*)d = pack8(acc[ai][bj][m][0], acc[ai][bj][m][1]); } }
        } else {
            const bool isq = pn < 14; bf16_t* buf = isq ? CQ : CKV; const int ld = isq ? 512 : 256, col0 = (isq ? (pn - 12) * BM : 0) + wc * 32 + 8 * fq;
#pragma unroll
            for (int ai = 0; ai < 2; ++ai)
#pragma unroll
                for (int m = 0; m < 4; ++m) { const int t = row0 + ai * HALF + m * 16; bf16_t* d = buf + (size_t)t * ld + col0; float ss = 0.f;
#pragma unroll
                    for (int bj = 0; bj < 2; ++bj) { const f32x4 v0 = acc[ai][bj][m][0], v1 = acc[ai][bj][m][1];
                        ss += (v0[0] * v0[0] + v0[1] * v0[1]) + (v0[2] * v0[2] + v0[3] * v0[3]) + (v1[0] * v1[0] + v1[1] * v1[1]) + (v1[2] * v1[2] + v1[3] * v1[3]);
                        if (F8U) { u32x2 o8; o8.x = pack4_fp8s(v0[0], v0[1], v0[2], v0[3], S_C); o8.y = pack4_fp8s(v1[0], v1[1], v1[2], v1[3], S_C); *(u32x2*)((unsigned char*)buf + (size_t)t * ld + col0 + bj * HALF) = o8; }
                        else *(u32x4*)(d + bj * HALF) = pack8(v0, v1); }
                    ss = xor32_sum(xor16_sum(ss));
                    if (fq == 0) { if (isq) SSQQ[(size_t)t * 8 + (pn - 12) * 4 + wc] = ss; else SSQK[(size_t)t * 4 + wc] = ss; } }
        }
    }
};
struct EpiUq {
    static constexpr bool PERM = true;
    static constexpr bool MIDSCALE = false;
    __device__ __forceinline__ float unit_scale(const Unit&) const { return 1.0f; }
    bf16_t* QM; const float *SSQQ, *COS, *SIN;
    __device__ __forceinline__ void operator()(const f32x4 (&acc)[2][2][4][2], const Unit& u, int wr, int wc, int fr, int fq) const {
        const int pn = u.pn, row0 = u.pm * BM + wr * 64 + fr;
#pragma unroll
        for (int ai = 0; ai < 2; ++ai)
#pragma unroll
            for (int m = 0; m < 4; ++m) { const int t = row0 + ai * HALF + m * 16, b = t >> 12, s = t & 4095;
                const f32x4 q0 = *(const f32x4*)(SSQQ + (size_t)t * 8), q1 = *(const f32x4*)(SSQQ + (size_t)t * 8 + 4);
                const float ssq = ((q0[0] + q0[1]) + (q0[2] + q0[3])) + ((q1[0] + q1[1]) + (q1[2] + q1[3]));
                const float r = 1.0f / sqrtf(ssq * (1.0f / 512.0f) + RMS_EPS);
                if (QK8B) {
                    unsigned char* Q8 = (unsigned char*)QM;
                    if (pn < 4) {
#pragma unroll
                        for (int bj = 0; bj < 2; ++bj) { const f32x4 v0 = acc[ai][bj][m][0], v1 = acc[ai][bj][m][1]; u32x2 o8; o8.x = pack4_fp8s(v0[0], v0[1], v0[2], v0[3], r * S_QK); o8.y = pack4_fp8s(v1[0], v1[1], v1[2], v1[3], r * S_QK);
                            *(u32x2*)(Q8 + ((size_t)(b * 8 + 2 * pn + bj) * SEQ + s) * 192 + wc * 32 + 8 * fq) = o8; }
                    } else { const float* cp = COS + (size_t)t * 32 + 8 * fq; const float* sp = SIN + (size_t)t * 32 + 8 * fq;
                        const f32x4 c0 = *(const f32x4*)cp, c1 = *(const f32x4*)(cp + 4), s0 = *(const f32x4*)sp, s1 = *(const f32x4*)(sp + 4), a0 = acc[ai][0][m][0], a1 = acc[ai][0][m][1], b0 = acc[ai][1][m][0], b1 = acc[ai][1][m][1];
                        const f32x4 x0 = a0 * c0 - b0 * s0, x1 = a1 * c1 - b1 * s1, y0 = b0 * c0 + a0 * s0, y1 = b1 * c1 + a1 * s1;
                        u32x2 v1, v2; v1.x = pack4_fp8s(x0[0], x0[1], x0[2], x0[3], r * S_QK); v1.y = pack4_fp8s(x1[0], x1[1], x1[2], x1[3], r * S_QK); v2.x = pack4_fp8s(y0[0], y0[1], y0[2], y0[3], r * S_QK); v2.y = pack4_fp8s(y1[0], y1[1], y1[2], y1[3], r * S_QK);
                        unsigned char* d8 = Q8 + ((size_t)(b * 8 + 4 * (pn - 4) + wc) * SEQ + s) * 192 + 128 + 8 * fq;
                        *(u32x2*)d8 = v1; *(u32x2*)(d8 + 32) = v2; }
                } else if (pn < 4) {
#pragma unroll
                    for (int bj = 0; bj < 2; ++bj) { bf16_t* d = QM + ((size_t)(b * 8 + 2 * pn + bj) * SEQ + s) * 192 + wc * 32 + 8 * fq;
                        *(u32x4*)d = pack8(acc[ai][bj][m][0] * r, acc[ai][bj][m][1] * r); }
                } else {
                    u32x4 w1, w2; rope_pair(acc, ai, m, COS + (size_t)t * 32 + 8 * fq, SIN + (size_t)t * 32 + 8 * fq, r, w1, w2);
                    bf16_t* d = QM + ((size_t)(b * 8 + 4 * (pn - 4) + wc) * SEQ + s) * 192 + 128 + 8 * fq;
                    *(u32x4*)d = w1; *(u32x4*)(d + 32) = w2;
                } }
    }
};
struct EpiUkv {
    static constexpr bool PERM = true;
    static constexpr bool MIDSCALE = false;
    __device__ __forceinline__ float unit_scale(const Unit&) const { return 1.0f; }
    bf16_t *KM, *VM; const float* SSQK;
    __device__ __forceinline__ void operator()(const f32x4 (&acc)[2][2][4][2], const Unit& u, int wr, int wc, int fr, int fq) const {
        const int pn = u.pn, row0 = u.pm * BM + wr * 64 + fr; bf16_t* base = (pn < 4) ? KM : VM; const int ld = (pn < 4) ? 192 : 128;
        float rs[2][4];
#pragma unroll
        for (int ai = 0; ai < 2; ++ai)
#pragma unroll
            for (int m = 0; m < 4; ++m) { const f32x4 q0 = *(const f32x4*)(SSQK + (size_t)(row0 + ai * HALF + m * 16) * 4);
                rs[ai][m] = 1.0f / sqrtf(((q0[0] + q0[1]) + (q0[2] + q0[3])) * (1.0f / 256.0f) + RMS_EPS); }
        asm volatile("" ::: "memory");
        if (PV8B && pn >= 4) { store_vt8(acc, u, wr, wc, fr, fq, (unsigned char*)VM, ((u.pm * BM) >> 12) * 8 + 2 * (pn & 3), rs); return; }
#pragma unroll
        for (int ai = 0; ai < 2; ++ai)
#pragma unroll
            for (int m = 0; m < 4; ++m) { const int t = row0 + ai * HALF + m * 16, b = t >> 12, s = t & 4095;
                const float r = rs[ai][m];
#pragma unroll
                for (int bj = 0; bj < 2; ++bj) {
                    if (QK8B && pn < 4) { const f32x4 v0 = acc[ai][bj][m][0], v1 = acc[ai][bj][m][1]; u32x2 o8; o8.x = pack4_fp8s(v0[0], v0[1], v0[2], v0[3], r * S_QK); o8.y = pack4_fp8s(v1[0], v1[1], v1[2], v1[3], r * S_QK);
                        *(u32x2*)((unsigned char*)KM + ((size_t)(b * 8 + 2 * (pn & 3) + bj) * SEQ + s) * 192 + wc * 32 + 8 * fq) = o8; continue; }
                    bf16_t* d = base + ((size_t)(b * 8 + 2 * (pn & 3) + bj) * SEQ + s) * ld + wc * 32 + 8 * fq;
                    *(u32x4*)d = pack8(acc[ai][bj][m][0] * r, acc[ai][bj][m][1] * r); } }
    }
};
struct EpiBranch {
    static constexpr bool PERM = true, MIDSCALE = F8B;
    __device__ __forceinline__ float unit_scale(const Unit&) const { return 1.0f; }
    bf16_t* Y; const bf16_t* GATES; unsigned char* Y8;
    __device__ __forceinline__ void mid(f32x4 (&acc)[2][2][4][2], const Unit& u, int which, int wr, int wc, int fr, int fq) const {
        const int row0 = u.pm * BM + wr * 64 + fr, col0 = u.pn * BM + wc * 32 + 8 * fq;
        const float sc = (which == 1) ? S_YB / S_YA : S_YC / S_YB;
        if constexpr (GATE8) {
            const unsigned char* gbase = (const unsigned char*)GATES + (size_t)row0 * 6144 + (which - 1) * 2048 + col0;
#pragma unroll
            for (int ai = 0; ai < 2; ++ai) {
                u32x2 P[4][2], Q[4][2];
#pragma unroll
                for (int m = 0; m < 4; ++m)
#pragma unroll
                    for (int bj = 0; bj < 2; ++bj) { const unsigned char* gp = gbase + (size_t)(ai * HALF + m * 16) * 6144 + bj * HALF; P[m][bj] = *(const u32x2*)gp; Q[m][bj] = *(const u32x2*)(gp + 2048); }
#pragma unroll
                for (int m = 0; m < 4; ++m)
#pragma unroll
                    for (int bj = 0; bj < 2; ++bj) { const u32x2 p = P[m][bj], q = Q[m][bj];
                        f32x4 r0, r1;
                        r0[0] = ub0(p.x) * __builtin_amdgcn_rcpf(ub0(q.x)); r0[1] = ub1(p.x) * __builtin_amdgcn_rcpf(ub1(q.x)); r0[2] = ub2(p.x) * __builtin_amdgcn_rcpf(ub2(q.x)); r0[3] = ub3(p.x) * __builtin_amdgcn_rcpf(ub3(q.x));
                        r1[0] = ub0(p.y) * __builtin_amdgcn_rcpf(ub0(q.y)); r1[1] = ub1(p.y) * __builtin_amdgcn_rcpf(ub1(q.y)); r1[2] = ub2(p.y) * __builtin_amdgcn_rcpf(ub2(q.y)); r1[3] = ub3(p.y) * __builtin_amdgcn_rcpf(ub3(q.y));
                        acc[ai][bj][m][0] = acc[ai][bj][m][0] * (r0 * sc); acc[ai][bj][m][1] = acc[ai][bj][m][1] * (r1 * sc); }
                asm volatile("" ::: "memory"); }
            return; }
        const bf16_t* gbase = GATES + (size_t)row0 * 6144 + (which - 1) * 2048 + col0;
#pragma unroll
        for (int ai = 0; ai < 2; ++ai) {
            u32x4 P[4][2], Q[4][2];
#pragma unroll
            for (int m = 0; m < 4; ++m)
#pragma unroll
                for (int bj = 0; bj < 2; ++bj) { const bf16_t* gp = gbase + (size_t)(ai * HALF + m * 16) * 6144 + bj * HALF; P[m][bj] = *(const u32x4*)gp; Q[m][bj] = *(const u32x4*)(gp + 2048); }
#pragma unroll
            for (int m = 0; m < 4; ++m)
#pragma unroll
                for (int bj = 0; bj < 2; ++bj) { const u32x4 p = P[m][bj], q = Q[m][bj];
                    f32x4 r0, r1;
                    r0[0] = bflo(p.x) * __builtin_amdgcn_rcpf(fmaxf(bflo(q.x), 1e-30f)); r0[1] = bfhi(p.x) * __builtin_amdgcn_rcpf(fmaxf(bfhi(q.x), 1e-30f));
                    r0[2] = bflo(p.y) * __builtin_amdgcn_rcpf(fmaxf(bflo(q.y), 1e-30f)); r0[3] = bfhi(p.y) * __builtin_amdgcn_rcpf(fmaxf(bfhi(q.y), 1e-30f));
                    r1[0] = bflo(p.z) * __builtin_amdgcn_rcpf(fmaxf(bflo(q.z), 1e-30f)); r1[1] = bfhi(p.z) * __builtin_amdgcn_rcpf(fmaxf(bfhi(q.z), 1e-30f));
                    r1[2] = bflo(p.w) * __builtin_amdgcn_rcpf(fmaxf(bflo(q.w), 1e-30f)); r1[3] = bfhi(p.w) * __builtin_amdgcn_rcpf(fmaxf(bfhi(q.w), 1e-30f));
                    acc[ai][bj][m][0] = acc[ai][bj][m][0] * (r0 * sc); acc[ai][bj][m][1] = acc[ai][bj][m][1] * (r1 * sc); }
            asm volatile("" ::: "memory"); }
    }
    __device__ __forceinline__ void operator()(const f32x4 (&acc)[2][2][4][2], const Unit& u, int wr, int wc, int fr, int fq) const {
        const int br = F8B ? 2 : u.aux, row0 = u.pm * BM + wr * 64 + fr, col0 = u.pn * BM + wc * 32 + 8 * fq;
        const float gsc = (F8B ? 1.0f / S_YC : 1.0f) * (GATE8 ? 1.0f / 255.0f : 1.0f);
#pragma unroll
        for (int ai = 0; ai < 2; ++ai)
#pragma unroll
            for (int m = 0; m < 4; ++m) { const int t = row0 + ai * HALF + m * 16;
#pragma unroll
                for (int bj = 0; bj < 2; ++bj) {
                    bf16_t* yp = Y + (size_t)t * 2048 + col0 + bj * HALF;
                    f32x4 v0 = acc[ai][bj][m][0] * gsc, v1 = acc[ai][bj][m][1] * gsc;
                    if constexpr (GATE8) { const u32x2 g8 = *(const u32x2*)((const unsigned char*)GATES + (size_t)t * 6144 + br * 2048 + col0 + bj * HALF);
                        v0[0] *= ub0(g8.x); v0[1] *= ub1(g8.x); v0[2] *= ub2(g8.x); v0[3] *= ub3(g8.x); v1[0] *= ub0(g8.y); v1[1] *= ub1(g8.y); v1[2] *= ub2(g8.y); v1[3] *= ub3(g8.y); }
                    else { const u32x4 gw = *(const u32x4*)(GATES + (size_t)t * 6144 + br * 2048 + col0 + bj * HALF);
                    v0[0] *= bflo(gw.x); v0[1] *= bfhi(gw.x); v0[2] *= bflo(gw.y); v0[3] *= bfhi(gw.y);
                    v1[0] *= bflo(gw.z); v1[1] *= bfhi(gw.z); v1[2] *= bflo(gw.w); v1[3] *= bfhi(gw.w); }
                    if constexpr (F8B) { u32x2 o; o.x = pack4_fp8s(v0[0], v0[1], v0[2], v0[3], S_Y); o.y = pack4_fp8s(v1[0], v1[1], v1[2], v1[3], S_Y); *(u32x2*)(Y8 + (size_t)t * 2048 + col0 + bj * HALF) = o; }
                    else { if (br > 0) { const u32x4 yw = *(const u32x4*)yp;
                            v0[0] += bflo(yw.x); v0[1] += bfhi(yw.x); v0[2] += bflo(yw.y); v0[3] += bfhi(yw.y);
                            v1[0] += bflo(yw.z); v1[1] += bfhi(yw.z); v1[2] += bflo(yw.w); v1[3] += bfhi(yw.w); }
                        *(u32x4*)yp = pack8(v0, v1); } } }
    }
};
struct EpiOut {
    static constexpr bool PERM = false;
    static constexpr bool MIDSCALE = false;
    __device__ __forceinline__ float unit_scale(const Unit&) const { return 1.0f; }
    const bf16_t* X; bf16_t* U; const float* G1;
    __device__ __forceinline__ void operator()(const f32x4 (&acc)[2][2][4][2], const Unit& u, int wr, int wc, int fr, int fq) const {
        const int row0 = u.pm * BM + wr * 64 + fr, col0 = u.pn * BM + wc * 32 + 4 * fq, b = (u.pm * BM) >> 12;
        f32x4 g[2][2], xb[2][2][2];
#pragma unroll
        for (int bj = 0; bj < 2; ++bj)
#pragma unroll
            for (int n = 0; n < 2; ++n) g[bj][n] = *(const f32x4*)(G1 + (size_t)b * 12288 + col0 + bj * HALF + n * 16);
#define EO_LOAD(k) do { const size_t xo_ = (size_t)(row0 + ((k) >> 2) * HALF + ((k) & 3) * 16) * 2048 + col0; \
        _Pragma("unroll") for (int bj = 0; bj < 2; ++bj) _Pragma("unroll") for (int n = 0; n < 2; ++n) xb[(k) % 2][bj][n] = ld_bf4(X + xo_ + bj * HALF + n * 16); asm volatile("" ::: "memory"); } while (0)
        EO_LOAD(0);
#pragma unroll
        for (int k = 0; k < 8; ++k) { const int ai = k >> 2, m = k & 3;
            if (k + 1 < 8) EO_LOAD(k + 1);
            bf16_t* up = U + (size_t)(row0 + ai * HALF + m * 16) * 2048 + col0;
#pragma unroll
            for (int bj = 0; bj < 2; ++bj)
#pragma unroll
                for (int n = 0; n < 2; ++n) *(u32x2*)(up + bj * HALF + n * 16) = pk_bf4(xb[k % 2][bj][n] * ALPHA + g[bj][n] * acc[ai][bj][m][n]);
            asm volatile("" ::: "memory"); }
#undef EO_LOAD
    }
};
struct EpiMoeUp {
    static constexpr bool PERM = true;
    static constexpr bool MIDSCALE = false;
    __device__ __forceinline__ float unit_scale(const Unit&) const { return 1.0f; }
    bf16_t* HID; const LAS float* GW;
    __device__ __forceinline__ void operator()(const f32x4 (&acc)[2][2][4][2], const Unit& u, int wr, int wc, int fr, int fq) const {
        const int row0 = u.pm * BM + wr * 64 + fr, col0 = u.pn * HALF + wc * 32 + 8 * fq;
#pragma unroll
        for (int ai = 0; ai < 2; ++ai)
#pragma unroll
            for (int m = 0; m < 4; ++m) { const int rr = row0 + ai * HALF + m * 16; const float gw = GW[((u.aux >> 8) & 1) * 256 + wr * 64 + fr + ai * HALF + m * 16];
                f32x4 v0, v1;
#pragma unroll
                for (int j = 0; j < 4; ++j) { const float a = acc[ai][0][m][0][j], b = acc[ai][0][m][1][j];
                    v0[j] = a * sigmoidf_(a) * acc[ai][1][m][0][j] * gw; v1[j] = b * sigmoidf_(b) * acc[ai][1][m][1][j] * gw; }
                if constexpr (F8D) { u32x2 o; o.x = pack4_fp8s(v0[0], v0[1], v0[2], v0[3], S_HID); o.y = pack4_fp8s(v1[0], v1[1], v1[2], v1[3], S_HID); *(u32x2*)((unsigned char*)HID + (size_t)rr * EH + col0) = o; }
                else *(u32x4*)(HID + (size_t)rr * EH + col0) = pack8(v0, v1); }
    }
};
struct EpiMoeDown {
    static constexpr bool PERM = true;
    static constexpr bool MIDSCALE = false;
    __device__ __forceinline__ float unit_scale(const Unit&) const { return 1.0f; }
    bf16_t* OS;
    __device__ __forceinline__ void operator()(const f32x4 (&acc)[2][2][4][2], const Unit& u, int wr, int wc, int fr, int fq) const {
        const int row0 = u.pm * BM + wr * 64 + fr, col0 = u.pn * BM + wc * 32 + 8 * fq;
#pragma unroll
        for (int ai = 0; ai < 2; ++ai)
#pragma unroll
            for (int m = 0; m < 4; ++m) { const int rr = row0 + ai * HALF + m * 16;
#pragma unroll
                for (int bj = 0; bj < 2; ++bj) *(u32x4*)(OS + (size_t)rr * 2048 + col0 + bj * HALF) = pack8(acc[ai][bj][m][0], acc[ai][bj][m][1]); }
    }
};
}

namespace att {
typedef int i32x4a __attribute__((ext_vector_type(4)));
typedef int i32x8a __attribute__((ext_vector_type(8)));
constexpr int NW = 8, QBLK = 32, KVBLK = 64;
#define SBAR() __builtin_amdgcn_sched_barrier(0)
__device__ __forceinline__ int crow(int r, int hi) { return (r & 3) + 8 * (r >> 2) + 4 * hi; }
template <int DK> __device__ __forceinline__ int kswz(int row, int colB) { return row * (2 * DK) + (colB ^ (((row >> 1) & 7) << 4)); }
template <int DV> __device__ __forceinline__ int v_st(int k, int c) { const int kk = (k & ~0xC) | ((k & 4) << 1) | ((k & 8) >> 1); return ((kk >> 3) * (DV / 32) + (c >> 5)) * 512 + ((kk & 7) * 32 + (c & 31)) * 2; }
__device__ __forceinline__ int v_rd_base(int lane) { return ((lane & 3) << 3) | (((lane >> 2) & 3) << 6) | (((lane >> 4) & 1) << 5) | (((lane >> 5) & 1) << 8); }
template <int OFF> __device__ __forceinline__ s16x4 tr_read(int vb) { s16x4 r; asm volatile("ds_read_b64_tr_b16 %0, %1 offset:%2" : "=&v"(r) : "v"(vb), "i"(OFF) : "memory"); return r; }

template <bool MASK>
__device__ __forceinline__ void partialSM(f32x16& p0, f32x16& p1, float& m_reg, float& mn, float& alpha, float C, float thr_raw, int kb, int hi, float ebias = 0.f) {
    if (MASK) {
#pragma unroll
        for (int r = 0; r < 16; ++r) { const int d0 = kb + crow(r, hi), d1 = d0 + 32;
            if (d0 < -128 || d0 > 128) p0[r] = -1e30f; if (d1 < -128 || d1 > 128) p1[r] = -1e30f; }
    }
    float pmax = p0[0];
#pragma unroll
    for (int r = 1; r < 16; ++r) pmax = fmaxf(pmax, p0[r]);
#pragma unroll
    for (int r = 0; r < 16; ++r) pmax = fmaxf(pmax, p1[r]);
    { auto rr = __builtin_amdgcn_permlane32_swap(__float_as_uint(pmax), __float_as_uint(pmax), false, false);
      pmax = fmaxf(__uint_as_float(rr[0]), __uint_as_float(rr[1])); }
    if (__builtin_expect(__all(pmax - m_reg <= thr_raw), 1)) { mn = m_reg; alpha = 1.f; }
    else { mn = fmaxf(m_reg, pmax); alpha = __builtin_amdgcn_exp2f((m_reg - mn) * C); m_reg = mn; }
    const float mnC = ebias - mn * C;
#pragma unroll
    for (int r = 0; r < 16; ++r) p0[r] = fmaf(p0[r], C, mnC);
#pragma unroll
    for (int r = 0; r < 16; ++r) p1[r] = fmaf(p1[r], C, mnC);
#pragma unroll
    for (int r = 0; r < 16; ++r) p0[r] = __builtin_amdgcn_exp2f(p0[r]);
}
__device__ __forceinline__ void finishSM(f32x16& p0, f32x16& p1, float alpha, float& l_reg, bf16x8& pa0, bf16x8& pa1, bf16x8& pa2, bf16x8& pa3) {
#pragma unroll
    for (int r = 0; r < 16; ++r) p1[r] = __builtin_amdgcn_exp2f(p1[r]);
    float ps = 0;
#pragma unroll
    for (int r = 0; r < 16; ++r) ps += p0[r];
#pragma unroll
    for (int r = 0; r < 16; ++r) ps += p1[r];
    { auto rr = __builtin_amdgcn_permlane32_swap(__float_as_uint(ps), __float_as_uint(ps), false, false);
      ps = __uint_as_float(rr[0]) + __uint_as_float(rr[1]); }
    l_reg = l_reg * alpha + ps;
#define PK4(P, BASE, OUT) do { unsigned a0 = cvt_pk_bf16(P[BASE + 0], P[BASE + 1]), a1 = cvt_pk_bf16(P[BASE + 2], P[BASE + 3]);   \
    unsigned b0 = cvt_pk_bf16(P[BASE + 4], P[BASE + 5]), b1 = cvt_pk_bf16(P[BASE + 6], P[BASE + 7]);                              \
    auto r0 = __builtin_amdgcn_permlane32_swap(a0, b0, false, false); auto r1 = __builtin_amdgcn_permlane32_swap(a1, b1, false, false); \
    u32x4 w = {r0[0], r1[0], r0[1], r1[1]}; OUT = *reinterpret_cast<bf16x8*>(&w); } while (0)
    PK4(p0, 0, pa0); PK4(p0, 8, pa1); PK4(p1, 0, pa2); PK4(p1, 8, pa3);
#undef PK4
}
__device__ __forceinline__ void finishSM8(f32x16& p0, f32x16& p1, float alpha, float& l_reg, i32x8a& P8) {
#pragma unroll
    for (int r = 0; r < 16; ++r) p1[r] = __builtin_amdgcn_exp2f(p1[r]);
    float ps = 0;
#pragma unroll
    for (int r = 0; r < 16; ++r) ps += p0[r];
#pragma unroll
    for (int r = 0; r < 16; ++r) ps += p1[r];
    { auto rr = __builtin_amdgcn_permlane32_swap(__float_as_uint(ps), __float_as_uint(ps), false, false);
      ps = __uint_as_float(rr[0]) + __uint_as_float(rr[1]); }
    l_reg = l_reg * alpha + ps;
#pragma unroll
    for (int g = 0; g < 4; ++g) { P8[g] = (int)pack4_fp8(p0[4 * g], p0[4 * g + 1], p0[4 * g + 2], p0[4 * g + 3]); P8[4 + g] = (int)pack4_fp8(p1[4 * g], p1[4 * g + 1], p1[4 * g + 2], p1[4 * g + 3]); }
}
__device__ __forceinline__ void finishSM8n(f32x16& p0, f32x16& p1, i32x8a& P8) {
#pragma unroll
    for (int r = 0; r < 16; ++r) p1[r] = __builtin_amdgcn_exp2f(p1[r]);
#pragma unroll
    for (int g = 0; g < 4; ++g) { P8[g] = (int)pack4_fp8(p0[4 * g], p0[4 * g + 1], p0[4 * g + 2], p0[4 * g + 3]); P8[4 + g] = (int)pack4_fp8(p1[4 * g], p1[4 * g + 1], p1[4 * g + 2], p1[4 * g + 3]); }
}
template <int DV> __device__ __forceinline__ void pv_all8(f32x16* o, const char* Vs, int vo0, int vo1, i32x8a P8) {
#pragma unroll
    for (int d = 0; d < DV / 32; ++d) { const i32x4a lo = *reinterpret_cast<const i32x4a*>(Vs + vo0 + d * 2048), hh = *reinterpret_cast<const i32x4a*>(Vs + vo1 + d * 2048);
        const i32x8a Vf = __builtin_shufflevector(lo, hh, 0, 1, 2, 3, 4, 5, 6, 7);
        o[d] = __builtin_amdgcn_mfma_scale_f32_32x32x64_f8f6f4(P8, Vf, o[d], 0, 0, 0, 0, 0, 0); }
}
template <int DK>
__device__ __forceinline__ void qkt(f32x16& p0, f32x16& p1, const char* Ks, const bf16x8* qr, int r32, int hi) {
    p0 = f32x16{}; p1 = f32x16{};
#pragma unroll
    for (int d0 = 0; d0 < DK / 16; ++d0) { const int cb = (d0 * 16 + hi * 8) * 2;
        const bf16x8 b0 = *reinterpret_cast<const bf16x8*>(Ks + kswz<DK>(r32, cb));
        const bf16x8 b1 = *reinterpret_cast<const bf16x8*>(Ks + kswz<DK>(32 + r32, cb));
        p0 = __builtin_amdgcn_mfma_f32_32x32x16_bf16(b0, qr[d0], p0, 0, 0, 0);
        p1 = __builtin_amdgcn_mfma_f32_32x32x16_bf16(b1, qr[d0], p1, 0, 0, 0); }
}
template <int DV, int D0> __device__ __forceinline__ void pv_one(f32x16& od, int vb, bf16x8 pa0, bf16x8 pa1, bf16x8 pa2, bf16x8 pa3) {
    constexpr int KS = (DV / 32) * 1024, HF = (DV / 32) * 512;
    const s16x4 l0 = tr_read<D0 * 512 + 0 * KS>(vb), h0 = tr_read<D0 * 512 + 0 * KS + HF>(vb), l1 = tr_read<D0 * 512 + 1 * KS>(vb), h1 = tr_read<D0 * 512 + 1 * KS + HF>(vb);
    const s16x4 l2 = tr_read<D0 * 512 + 2 * KS>(vb), h2 = tr_read<D0 * 512 + 2 * KS + HF>(vb), l3 = tr_read<D0 * 512 + 3 * KS>(vb), h3 = tr_read<D0 * 512 + 3 * KS + HF>(vb);
    asm volatile("s_waitcnt lgkmcnt(0)" ::: "memory"); SBAR();
#define PK(L, H) (bf16x8){L[0], L[1], L[2], L[3], H[0], H[1], H[2], H[3]}
    od = __builtin_amdgcn_mfma_f32_32x32x16_bf16(pa0, PK(l0, h0), od, 0, 0, 0);
    od = __builtin_amdgcn_mfma_f32_32x32x16_bf16(pa1, PK(l1, h1), od, 0, 0, 0);
    od = __builtin_amdgcn_mfma_f32_32x32x16_bf16(pa2, PK(l2, h2), od, 0, 0, 0);
    od = __builtin_amdgcn_mfma_f32_32x32x16_bf16(pa3, PK(l3, h3), od, 0, 0, 0);
#undef PK
}
template <int DV, int KSI> __device__ __forceinline__ void pv_ks(f32x16* o, int vb, bf16x8 pa) {
    constexpr int KS = (DV / 32) * 1024, HF = (DV / 32) * 512;
    const s16x4 l0 = tr_read<0 * 512 + KSI * KS>(vb), h0 = tr_read<0 * 512 + KSI * KS + HF>(vb), l1 = tr_read<1 * 512 + KSI * KS>(vb), h1 = tr_read<1 * 512 + KSI * KS + HF>(vb);
#define PK(L, H) (bf16x8){L[0], L[1], L[2], L[3], H[0], H[1], H[2], H[3]}
    if constexpr (DV == 128) {
        const s16x4 l2 = tr_read<2 * 512 + KSI * KS>(vb), h2 = tr_read<2 * 512 + KSI * KS + HF>(vb), l3 = tr_read<3 * 512 + KSI * KS>(vb), h3 = tr_read<3 * 512 + KSI * KS + HF>(vb);
        asm volatile("s_waitcnt lgkmcnt(0)" ::: "memory"); SBAR();
        o[0] = __builtin_amdgcn_mfma_f32_32x32x16_bf16(pa, PK(l0, h0), o[0], 0, 0, 0); o[1] = __builtin_amdgcn_mfma_f32_32x32x16_bf16(pa, PK(l1, h1), o[1], 0, 0, 0);
        o[2] = __builtin_amdgcn_mfma_f32_32x32x16_bf16(pa, PK(l2, h2), o[2], 0, 0, 0); o[3] = __builtin_amdgcn_mfma_f32_32x32x16_bf16(pa, PK(l3, h3), o[3], 0, 0, 0);
    } else {
        asm volatile("s_waitcnt lgkmcnt(0)" ::: "memory"); SBAR();
        o[0] = __builtin_amdgcn_mfma_f32_32x32x16_bf16(pa, PK(l0, h0), o[0], 0, 0, 0); o[1] = __builtin_amdgcn_mfma_f32_32x32x16_bf16(pa, PK(l1, h1), o[1], 0, 0, 0);
    }
#undef PK
}
template <int DV> __device__ __forceinline__ void pv_all(f32x16* o, int vb, bf16x8 pa0, bf16x8 pa1, bf16x8 pa2, bf16x8 pa3) {
    pv_ks<DV, 0>(o, vb, pa0); pv_ks<DV, 1>(o, vb, pa1); pv_ks<DV, 2>(o, vb, pa2); pv_ks<DV, 3>(o, vb, pa3);
}

template <int DK, int DV, int SD, bool MASK>
__device__ __forceinline__ void attn_body(const bf16_t* __restrict__ Qw0, int ldq, const bf16_t* __restrict__ Kh, int ldk, const bf16_t* __restrict__ Vh, int ldv, int NT,
                                          float C, float thr_raw, float m_init, float l_init, int qrel, char* lds, f32x16 (&o)[DV / 32], float& l_out, int wv) {
    constexpr int NCK = DK / 8, NCV = DV / 8, PKN = DK / 64, PVN = DV / 64, NDK = DK / 16, NOB = DV / 32;
    constexpr int SHM_K = KVBLK * DK * 2, SHM_V = KVBLK * DV * 2;
    const int tid = opaque_tid(wv), wid = tid >> 6, lane = tid & 63, r32 = lane & 31, hi = lane >> 5;
    char* V_lds = lds; char* K_lds = lds + 2 * SHM_V;
    float* wsf = (float*)(lds + 2 * SHM_V + 2 * SHM_K) + wid * 64; float* al_l = wsf + 32;
    float m_reg = m_init, l_reg = l_init;
#pragma unroll
    for (int d = 0; d < NOB; ++d) o[d] = f32x16{};
    bf16x8 qr[NDK];
    const bf16_t* Qw = Qw0 + (size_t)r32 * ldq + hi * 8;
#pragma unroll
    for (int d0 = 0; d0 < NDK; ++d0) qr[d0] = *reinterpret_cast<const bf16x8*>(Qw + d0 * 16);
    int kg[PKN], kl[PKN], vg[PVN], vl[PVN];
#pragma unroll
    for (int i = 0; i < PKN; ++i) { const int q = tid + 512 * i, row = q / NCK, ch = q % NCK; kg[i] = row * ldk + ch * 8; kl[i] = kswz<DK>(row, ch * 16); }
#pragma unroll
    for (int i = 0; i < PVN; ++i) { const int q = tid + 512 * i, row = q / NCV, ch = q % NCV; vg[i] = row * ldv + ch * 8; vl[i] = v_st<DV>(row, ch * 8); }
    const int vb0 = (int)(uintptr_t)V_lds + v_rd_base(lane);
    const int qpos = qrel + r32;
    bf16x8 ks_[SD][PKN], vs_[SD][PVN];
#define SLOAD(i, k0) do { _Pragma("unroll") for (int _p = 0; _p < PVN; ++_p) vs_[i][_p] = *reinterpret_cast<const bf16x8*>(Vh + (size_t)(k0) * ldv + vg[_p]); \
    _Pragma("unroll") for (int _p = 0; _p < PKN; ++_p) ks_[i][_p] = *reinterpret_cast<const bf16x8*>(Kh + (size_t)(k0) * ldk + kg[_p]); } while (0)
#define SWRITE(b, i) do { _Pragma("unroll") for (int _p = 0; _p < PVN; ++_p) *reinterpret_cast<bf16x8*>(V_lds + (b) * SHM_V + vl[_p]) = vs_[i][_p]; \
    _Pragma("unroll") for (int _p = 0; _p < PKN; ++_p) *reinterpret_cast<bf16x8*>(K_lds + (b) * SHM_K + kl[_p]) = ks_[i][_p]; } while (0)
#define SWAIT() do { if constexpr (SD == 2) asm volatile("s_waitcnt vmcnt(%0)" :: "n"(PKN + PVN) : "memory"); else asm volatile("s_waitcnt vmcnt(0)" ::: "memory"); } while (0)
#define RESC(a) do { if (__any((a) < 1.f)) { if (hi == 0) al_l[r32] = (a); asm volatile("s_waitcnt lgkmcnt(0)" ::: "memory"); \
    _Pragma("unroll") for (int _d = 0; _d < NOB; ++_d) _Pragma("unroll") for (int _r = 0; _r < 16; ++_r) o[_d][_r] *= al_l[crow(_r, hi)]; } } while (0)
    f32x16 pA0, pA1, pB0, pB1; float mnA, mnB, alA, alB; bf16x8 pa0, pa1, pa2, pa3;
    constexpr int SE = 0, SO = SD - 1;
    SLOAD(SE, 0); asm volatile("s_waitcnt vmcnt(0)" ::: "memory"); SWRITE(0, SE); __syncthreads();
    qkt<DK>(pA0, pA1, K_lds, qr, r32, hi); partialSM<MASK>(pA0, pA1, m_reg, mnA, alA, C, thr_raw, 0 - qpos, hi);
    SLOAD(SO, KVBLK); if constexpr (SD == 2) { if (2 < NT) SLOAD(SE, 2 * KVBLK); }
    SWAIT(); SWRITE(1, SO); __syncthreads();
    for (int j = 1; j + 1 < NT; j += 2) {
        SBAR(); qkt<DK>(pB0, pB1, K_lds + SHM_K, qr, r32, hi);
        finishSM(pA0, pA1, alA, l_reg, pa0, pa1, pa2, pa3); SBAR();
        SLOAD(SO, (j + SD) * KVBLK); SBAR();
        pv_all<DV>(o, vb0, pa0, pa1, pa2, pa3); partialSM<MASK>(pB0, pB1, m_reg, mnB, alB, C, thr_raw, j * KVBLK - qpos, hi);
        __syncthreads(); SWAIT(); SWRITE(0, SE);
        RESC(alB); __syncthreads();
        SBAR(); qkt<DK>(pA0, pA1, K_lds, qr, r32, hi);
        finishSM(pB0, pB1, alB, l_reg, pa0, pa1, pa2, pa3); SBAR();
        if (SD == 1 || j + 3 < NT) SLOAD(SE, (j + 1 + SD) * KVBLK); SBAR();
        pv_all<DV>(o, vb0 + SHM_V, pa0, pa1, pa2, pa3); partialSM<MASK>(pA0, pA1, m_reg, mnA, alA, C, thr_raw, (j + 1) * KVBLK - qpos, hi);
        __syncthreads(); SWAIT(); SWRITE(1, SO);
        RESC(alA); __syncthreads();
    }
    SBAR(); qkt<DK>(pB0, pB1, K_lds + SHM_K, qr, r32, hi);
    finishSM(pA0, pA1, alA, l_reg, pa0, pa1, pa2, pa3); SBAR();
    pv_all<DV>(o, vb0, pa0, pa1, pa2, pa3); partialSM<MASK>(pB0, pB1, m_reg, mnB, alB, C, thr_raw, (NT - 1) * KVBLK - qpos, hi);
    __syncthreads(); RESC(alB);
    finishSM(pB0, pB1, alB, l_reg, pa0, pa1, pa2, pa3); SBAR();
    pv_all<DV>(o, vb0 + SHM_V, pa0, pa1, pa2, pa3);
    l_out = l_reg;
#undef SLOAD
#undef SWRITE
#undef SWAIT
#undef RESC
}
template <int DK, int DV, bool MASK, bool PV8 = false, bool QK8 = false>
__device__ __forceinline__ void attn_body_dma(const bf16_t* __restrict__ Qw0, int ldq, const bf16_t* __restrict__ Kh, int ldk, const bf16_t* __restrict__ Vh, int ldv, int NT,
                                              float C, float thr_raw, float m_init, float l_init, int qrel, char* lds, f32x16 (&o)[DV / 32], float& l_out, int wv, f32x16* lrow = nullptr) {
    constexpr int NCK = DK / 8, NC8 = DK / 16, NQ8 = DK / 64, PKN = QK8 ? (KVBLK * NC8 + 511) / 512 : DK / 64, PVN = PV8 ? (DV + 127) / 128 : DV / 64, NDK = DK / 16, NOB = DV / 32;
    constexpr int SHM_K = QK8 ? KVBLK * DK : KVBLK * DK * 2, SHM_V = PV8 ? DV * 64 : KVBLK * DV * 2, SLOT = SHM_K + SHM_V;
    static_assert(!QK8 || (DK % 64 == 0 && PV8), "fp8 Q K^T: head dim a multiple of 64, with the fp8 P V path");
    static_assert(!PV8 || DV <= 128, "fp8 P V: one DMA instruction per V^T tile");
    const float ebias = PV8 ? PV8_LOG2S : 0.f;
    const int tid = opaque_tid(wv), wid = __builtin_amdgcn_readfirstlane(tid >> 6), lane = tid & 63, r32 = lane & 31, hi = lane >> 5;
    float* wsf = (float*)(lds + 3 * SLOT) + wid * 64; float* al_l = wsf + 32;
    float m_reg = m_init, l_reg = l_init;
#pragma unroll
    for (int d = 0; d < NOB; ++d) o[d] = f32x16{};
    bf16x8 qr[QK8 ? 1 : NDK]; i32x8a q8[QK8 ? NQ8 : 1];
    if constexpr (QK8) {
#pragma unroll
        for (int d = 0; d < NQ8; ++d) { const i32x4a* qp = (const i32x4a*)((const unsigned char*)Qw0 + (size_t)r32 * ldq + d * 64 + hi * 32); const i32x4a qa = qp[0], qb = qp[1]; q8[d] = __builtin_shufflevector(qa, qb, 0, 1, 2, 3, 4, 5, 6, 7); } }
    else { const bf16_t* Qw = Qw0 + (size_t)r32 * ldq + hi * 8;
#pragma unroll
        for (int d0 = 0; d0 < NDK; ++d0) qr[d0] = *reinterpret_cast<const bf16x8*>(Qw + d0 * 16); }
    const __amdgpu_buffer_rsrc_t rsK = __builtin_amdgcn_make_buffer_rsrc((void*)Kh, (short)0, 0xFFFFFFFF, 0x00020000);
    const __amdgpu_buffer_rsrc_t rsV = __builtin_amdgcn_make_buffer_rsrc((void*)Vh, (short)0, 0xFFFFFFFF, 0x00020000);
    unsigned voK[PKN], voV[PVN];
#pragma unroll
    for (int n = 0; n < PKN; ++n) { const int q = n * 512 + wid * 64 + lane;
        if constexpr (QK8) { const int row = (q / NC8) & 63, pp = q % NC8; voK[n] = (unsigned)(row * ldk + ((pp ^ ((row >> 2) & 3)) << 4)); }
        else { const int row = q / NCK, ch = q % NCK; voK[n] = (unsigned)(row * ldk * 2 + ((ch ^ ((row >> 1) & 7)) << 4)); } }
#pragma unroll
    for (int n = 0; n < PVN; ++n) { const int q = n * 512 + wid * 64 + lane;
        if constexpr (PV8) { const int row = q >> 2, pp = q & 3; voV[n] = (unsigned)(row * ldv + ((pp ^ ((row >> 2) & 3)) << 4)); }
        else { const int sub = q >> 5, key8 = (q & 31) >> 2, cc = q & 3, kk = (sub / (DV / 32)) * 8 + key8, col = (sub % (DV / 32)) * 32 + cc * 8;
            const int k = (kk & ~0xC) | ((kk & 4) << 1) | ((kk & 8) >> 1); voV[n] = (unsigned)(k * ldv * 2 + col * 2); } }
    LAS unsigned char* ldsl = (LAS unsigned char*)(uintptr_t)(unsigned)(uintptr_t)lds;
    const unsigned tstepK = QK8 ? (unsigned)(KVBLK * ldk) : (unsigned)(KVBLK * ldk * 2), tstepV = PV8 ? (unsigned)KVBLK : (unsigned)(KVBLK * ldv * 2);
#define ADMA(tile, slot) do { { _Pragma("unroll") for (int _n = 0; _n < PKN; ++_n) if (!QK8 || _n * 512 + wid * 64 < KVBLK * NC8) __builtin_amdgcn_raw_ptr_buffer_load_lds(rsK, (LAS unsigned*)(ldsl + (slot) * SLOT + _n * 8192 + wid * 1024), 16, voK[_n], (unsigned)(tile) * tstepK, 0, 0); } \
    _Pragma("unroll") for (int _n = 0; _n < PVN; ++_n) if (!PV8 || wid * 64 < DV * 4) __builtin_amdgcn_raw_ptr_buffer_load_lds(rsV, (LAS unsigned*)(ldsl + (slot) * SLOT + SHM_K + _n * 8192 + wid * 1024), 16, voV[_n], (unsigned)(tile) * tstepV, 0, 0); } while (0)
#define ARESC(a) do { if (__any((a) < 1.f)) { if (hi == 0) al_l[r32] = (a); asm volatile("s_waitcnt lgkmcnt(0)" ::: "memory"); \
    _Pragma("unroll") for (int _d = 0; _d < NOB; ++_d) _Pragma("unroll") for (int _r = 0; _r < 16; ++_r) o[_d][_r] *= al_l[crow(_r, hi)]; \
    if constexpr (PV8) { _Pragma("unroll") for (int _r = 0; _r < 16; ++_r) lacc[_r] *= al_l[crow(_r, hi)]; } } } while (0)
#define ALAND() do { asm volatile("s_waitcnt vmcnt(0)" ::: "memory"); __syncthreads(); } while (0)
    const int vbase = (int)(uintptr_t)lds + SHM_K + v_rd_base(lane);
    const int qpos = qrel + r32;
    f32x16 pA0, pA1, pB0, pB1; float mnA, mnB, alA, alB; bf16x8 pa0, pa1, pa2, pa3; i32x8a P8;
    f32x16 lacc;
#pragma unroll
    for (int r = 0; r < 16; ++r) lacc[r] = PV8 ? l_init * PV8_SCALE : 0.f;
    static_assert(true, "");
    i32x8a ones8; { int one_ = 0x38383838; asm volatile("" : "+v"(one_));
#pragma unroll
        for (int r = 0; r < 8; ++r) ones8[r] = one_; }
    const int k8o0 = r32 * DK + (((2 * hi) ^ ((r32 >> 2) & 3)) << 4), k8o1 = r32 * DK + (((2 * hi + 1) ^ ((r32 >> 2) & 3)) << 4);
    const int v8sw = (r32 >> 2) & 3, v8o0 = SHM_K + r32 * 64 + (((2 * hi) ^ v8sw) << 4), v8o1 = SHM_K + r32 * 64 + (((2 * hi + 1) ^ v8sw) << 4);
#define AQK(P0, P1, S_) do { if constexpr (QK8) { const char* kb_ = lds + (S_) * SLOT; P0 = f32x16{}; P1 = f32x16{}; \
        _Pragma("unroll") for (int d_ = 0; d_ < NQ8; ++d_) { \
        const i32x8a k0_ = __builtin_shufflevector(*reinterpret_cast<const i32x4a*>(kb_ + k8o0 + d_ * 64), *reinterpret_cast<const i32x4a*>(kb_ + k8o1 + d_ * 64), 0, 1, 2, 3, 4, 5, 6, 7); \
        const i32x8a k1_ = __builtin_shufflevector(*reinterpret_cast<const i32x4a*>(kb_ + k8o0 + d_ * 64 + 32 * DK), *reinterpret_cast<const i32x4a*>(kb_ + k8o1 + d_ * 64 + 32 * DK), 0, 1, 2, 3, 4, 5, 6, 7); \
        P0 = __builtin_amdgcn_mfma_scale_f32_32x32x64_f8f6f4(k0_, q8[d_], P0, 0, 0, 0, 0, 0, 0); P1 = __builtin_amdgcn_mfma_scale_f32_32x32x64_f8f6f4(k1_, q8[d_], P1, 0, 0, 0, 0, 0, 0); } } \
        else qkt<DK>(P0, P1, lds + (S_) * SLOT, qr, r32, hi); } while (0)
#define AFIN(P0, P1, AL) do { if constexpr (PV8) finishSM8n(P0, P1, P8); else finishSM(P0, P1, AL, l_reg, pa0, pa1, pa2, pa3); } while (0)
#define APV(S_) do { if constexpr (PV8) { pv_all8<DV>(o, lds + (S_) * SLOT, v8o0, v8o1, P8); lacc = __builtin_amdgcn_mfma_scale_f32_32x32x64_f8f6f4(P8, ones8, lacc, 0, 0, 0, 0, 0, 0); } else pv_all<DV>(o, vbase + (S_) * SLOT, pa0, pa1, pa2, pa3); } while (0)
    __syncthreads();
    ADMA(0, 0); ADMA(1, 1); ALAND();
    AQK(pA0, pA1, 0); partialSM<MASK>(pA0, pA1, m_reg, mnA, alA, C, thr_raw, 0 - qpos, hi, ebias);
    int sj = 1, sp = 0, sn = 2;
    for (int j = 1; j + 1 < NT; j += 2) {
        ADMA(j + 1, sn);
        SBAR(); AQK(pB0, pB1, sj);
        AFIN(pA0, pA1, alA); SBAR();
        APV(sp); partialSM<MASK>(pB0, pB1, m_reg, mnB, alB, C, thr_raw, j * KVBLK - qpos, hi, ebias);
        ARESC(alB); ALAND();
        sp = sj; sj = sn; sn = (sn == 2) ? 0 : sn + 1;
        if (j + 2 < NT) ADMA(j + 2, sn);
        SBAR(); AQK(pA0, pA1, sj);
        AFIN(pB0, pB1, alB); SBAR();
        APV(sp); partialSM<MASK>(pA0, pA1, m_reg, mnA, alA, C, thr_raw, (j + 1) * KVBLK - qpos, hi, ebias);
        ARESC(alA); ALAND();
        sp = sj; sj = sn; sn = (sn == 2) ? 0 : sn + 1;
    }
    SBAR(); AQK(pB0, pB1, sj);
    AFIN(pA0, pA1, alA); SBAR();
    APV(sp); partialSM<MASK>(pB0, pB1, m_reg, mnB, alB, C, thr_raw, (NT - 1) * KVBLK - qpos, hi, ebias);
    ARESC(alB);
    AFIN(pB0, pB1, alB); SBAR();
    APV(sj);
    l_out = l_reg;
    if constexpr (PV8) { if (lrow) *lrow = lacc; }
#undef ADMA
#undef ARESC
#undef ALAND
#undef AFIN
#undef AQK
#undef APV
}
template <int DK, int DV, bool MASK>
__device__ __forceinline__ void attn_body_simple(const bf16_t* __restrict__ Qw0, int ldq, const bf16_t* __restrict__ Kh, int ldk, const bf16_t* __restrict__ Vh, int ldv, int NT,
                                                 float C, float thr_raw, float m_init, float l_init, int qrel, char* lds, f32x16 (&o)[DV / 32], float& l_out, int wv) {
    constexpr int NCK = DK / 8, NCV = DV / 8, PKN = DK / 64, PVN = DV / 64, NDK = DK / 16, NOB = DV / 32;
    constexpr int SHM_K = KVBLK * DK * 2, SHM_V = KVBLK * DV * 2;
    const int tid = opaque_tid(wv), wid = tid >> 6, lane = tid & 63, r32 = lane & 31, hi = lane >> 5;
    char* V_lds = lds; char* K_lds = lds + 2 * SHM_V;
    float* wsf = (float*)(lds + 2 * SHM_V + 2 * SHM_K) + wid * 64; float* al_l = wsf + 32;
    float m_reg = m_init, l_reg = l_init;
#pragma unroll
    for (int d = 0; d < NOB; ++d) o[d] = f32x16{};
    bf16x8 qr[NDK];
    const bf16_t* Qw = Qw0 + (size_t)r32 * ldq + hi * 8;
#pragma unroll
    for (int d0 = 0; d0 < NDK; ++d0) qr[d0] = *reinterpret_cast<const bf16x8*>(Qw + d0 * 16);
    int kg[PKN], kl[PKN], vg[PVN], vl[PVN];
#pragma unroll
    for (int i = 0; i < PKN; ++i) { const int q = tid + 512 * i, row = q / NCK, ch = q % NCK; kg[i] = row * ldk + ch * 8; kl[i] = kswz<DK>(row, ch * 16); }
#pragma unroll
    for (int i = 0; i < PVN; ++i) { const int q = tid + 512 * i, row = q / NCV, ch = q % NCV; vg[i] = row * ldv + ch * 8; vl[i] = v_st<DV>(row, ch * 8); }
    const int vb0 = (int)(uintptr_t)V_lds + v_rd_base(lane);
    const int qpos = qrel + r32;
    bf16x8 ks_[PKN], vs_[PVN];
#define SLOAD1(k0) do { _Pragma("unroll") for (int _p = 0; _p < PVN; ++_p) vs_[_p] = *reinterpret_cast<const bf16x8*>(Vh + (size_t)(k0) * ldv + vg[_p]); \
    _Pragma("unroll") for (int _p = 0; _p < PKN; ++_p) ks_[_p] = *reinterpret_cast<const bf16x8*>(Kh + (size_t)(k0) * ldk + kg[_p]); } while (0)
#define SWRITE1(b) do { _Pragma("unroll") for (int _p = 0; _p < PVN; ++_p) *reinterpret_cast<bf16x8*>(V_lds + (b) * SHM_V + vl[_p]) = vs_[_p]; \
    _Pragma("unroll") for (int _p = 0; _p < PKN; ++_p) *reinterpret_cast<bf16x8*>(K_lds + (b) * SHM_K + kl[_p]) = ks_[_p]; } while (0)
    SLOAD1(0); asm volatile("s_waitcnt vmcnt(0)" ::: "memory"); SWRITE1(0); __syncthreads();
    for (int j = 0; j < NT; ++j) {
        const int bsel = j & 1;
        if (j + 1 < NT) SLOAD1((j + 1) * KVBLK);
        SBAR();
        f32x16 p0, p1; float mn, al; bf16x8 pa0, pa1, pa2, pa3;
        qkt<DK>(p0, p1, K_lds + bsel * SHM_K, qr, r32, hi);
        partialSM<MASK>(p0, p1, m_reg, mn, al, C, thr_raw, j * KVBLK - qpos, hi);
        if (__any(al < 1.f)) { if (hi == 0) al_l[r32] = al; asm volatile("s_waitcnt lgkmcnt(0)" ::: "memory");
#pragma unroll
            for (int d = 0; d < NOB; ++d)
#pragma unroll
                for (int r = 0; r < 16; ++r) o[d][r] *= al_l[crow(r, hi)]; }
        finishSM(p0, p1, al, l_reg, pa0, pa1, pa2, pa3); SBAR();
        pv_all<DV>(o, vb0 + bsel * SHM_V, pa0, pa1, pa2, pa3);
        if (j + 1 < NT) { asm volatile("s_waitcnt vmcnt(0)" ::: "memory"); SWRITE1(bsel ^ 1); }
        __syncthreads();
    }
    l_out = l_reg;
#undef SLOAD1
#undef SWRITE1
}
__device__ __forceinline__ void row_rcp(float l_reg, char* lds, int SHM_KV, float (&rli)[16], int wv) {
    const int tid = opaque_tid(wv), wid = tid >> 6, lane = tid & 63, r32 = lane & 31, hi = lane >> 5;
    float* li_l = (float*)(lds + SHM_KV) + wid * 64;
    if (hi == 0) li_l[r32] = l_reg;
    asm volatile("s_waitcnt lgkmcnt(0)" ::: "memory");
#pragma unroll
    for (int r = 0; r < 16; ++r) rli[r] = __builtin_amdgcn_rcpf(li_l[crow(r, hi)]);
    asm volatile("s_waitcnt lgkmcnt(0)" ::: "memory");
}
}

struct Args { const void* in[27]; float* out; unsigned char* ws; int ph_lo, ph_hi; };

typedef const __attribute__((address_space(4))) Args* KArgs;
__device__ __forceinline__ KArgs get_ka() { KArgs k = (KArgs)__builtin_amdgcn_kernarg_segment_ptr(); asm volatile("" : "+s"(k)); return k; }

struct Ctx {
    LAS unsigned char* lds; char* ldsg; int tid, lane, wave, G, gw, NGW;
    unsigned char* ws;
};

template <bool F8>
__device__ __forceinline__ void transpose_load(f32x4 (&v)[16], const float* W, int ldn, int csA, int csB, int k0, int lane) {
    const int rg = lane >> 4, c16 = lane & 15, cs = (c16 < 8) ? csA : csB;
    if (cs >= 0) {
#pragma unroll
        for (int i = 0; i < 16; ++i) v[i] = __builtin_nontemporal_load((const f32x4*)(W + (size_t)(k0 + 4 * i + rg) * ldn + cs + (c16 & 7) * 4));
    } else {
#pragma unroll
        for (int i = 0; i < 16; ++i) v[i] = (f32x4){0.f, 0.f, 0.f, 0.f};
    }
}
template <bool F8>
__device__ __forceinline__ void transpose_store(f32x4 (&v)[16], int k0, bf16_t* WT, int K, int nrow0, const float* kscale, LAS float* scr, int lane, int kdst) {
    const int rg = lane >> 4, c16 = lane & 15;
#pragma unroll
    for (int i = 0; i < 16; ++i) { const int kk = 4 * i + rg; if (kscale) v[i] = v[i] * kscale[k0 + kk];
        LAS float* p = scr + kk * 65 + c16 * 4; p[0] = v[i][0]; p[1] = v[i][1]; p[2] = v[i][2]; p[3] = v[i][3]; }
    LDS_WAIT(); asm volatile("" ::: "memory");
    const int c = lane & 7;
#pragma unroll
    for (int j = 0; j < 8; ++j) { const int n = (lane >> 3) + 8 * j; const LAS float* q = scr + (8 * c) * 65 + n;
        if constexpr (F8) { u32x2 o; o.x = pack4_fp8(q[0 * 65] * 64.f, q[1 * 65] * 64.f, q[2 * 65] * 64.f, q[3 * 65] * 64.f); o.y = pack4_fp8(q[4 * 65] * 64.f, q[5 * 65] * 64.f, q[6 * 65] * 64.f, q[7 * 65] * 64.f);
            *(u32x2*)((unsigned char*)WT + (size_t)(nrow0 + n) * K + kdst + k0 + 8 * c) = o; }
        else { u32x4 o; o.x = cvt_pk_bf16(q[0 * 65], q[1 * 65]); o.y = cvt_pk_bf16(q[2 * 65], q[3 * 65]); o.z = cvt_pk_bf16(q[4 * 65], q[5 * 65]); o.w = cvt_pk_bf16(q[6 * 65], q[7 * 65]);
            *(u32x4*)(WT + (size_t)(nrow0 + n) * K + k0 + 8 * c) = o; } }
    LDS_WAIT(); asm volatile("" ::: "memory");
}
template <bool F8>
__device__ __forceinline__ void cvt_item(const float* W, int ldn, int csA, int csB, int kb, bf16_t* WT, int K, int nrow0, const float* kscale, LAS float* scr, int lane, int kdst = 0) {
    if constexpr (F8) { f32x4 va[16], vb[16];
        transpose_load<true>(va, W, ldn, csA, csB, kb * 128, lane); transpose_load<true>(vb, W, ldn, csA, csB, kb * 128 + 64, lane);
        transpose_store<true>(va, kb * 128, WT, K, nrow0, kscale, scr, lane, kdst); transpose_store<true>(vb, kb * 128 + 64, WT, K, nrow0, kscale, scr, lane, kdst); }
    else { f32x4 va[16]; transpose_load<false>(va, W, ldn, csA, csB, kb * 64, lane); transpose_store<false>(va, kb * 64, WT, K, nrow0, kscale, scr, lane, 0); }
}
template <bool F8>
__device__ __forceinline__ void transpose_item(const float* W, int ldn, int csrc, int k0, bf16_t* WT, int K, int nrow0, const float* kscale, LAS float* scr, int lane) {
    if (csrc >= 0) {
        f32x4 v[8];
#pragma unroll
        for (int i = 0; i < 8; ++i) v[i] = *(const f32x4*)(W + (size_t)(k0 + 8 * i + (lane >> 3)) * ldn + csrc + (lane & 7) * 4);
#pragma unroll
        for (int i = 0; i < 8; ++i) { const int kk = 8 * i + (lane >> 3); if (kscale) v[i] = v[i] * kscale[k0 + kk];
            LAS float* d = scr + kk * 33 + (lane & 7) * 4; d[0] = v[i][0]; d[1] = v[i][1]; d[2] = v[i][2]; d[3] = v[i][3]; }
    } else {
#pragma unroll 8
        for (int i = 0; i < 32; ++i) { const int kk = 2 * i + (lane >> 5); scr[kk * 33 + (lane & 31)] = 0.f; }
    }
    LDS_WAIT(); asm volatile("" ::: "memory");
    const int c = lane & 7;
#pragma unroll
    for (int j = 0; j < 4; ++j) { const int n = (lane >> 3) + 8 * j; const LAS float* s = scr + (8 * c) * 33 + n;
        if constexpr (F8) {
            u32x2 o; o.x = pack4_fp8(s[0 * 33] * 64.f, s[1 * 33] * 64.f, s[2 * 33] * 64.f, s[3 * 33] * 64.f); o.y = pack4_fp8(s[4 * 33] * 64.f, s[5 * 33] * 64.f, s[6 * 33] * 64.f, s[7 * 33] * 64.f);
            *(u32x2*)((unsigned char*)WT + (size_t)(nrow0 + n) * K + k0 + 8 * c) = o;
        } else {
        u32x4 o; o.x = cvt_pk_bf16(s[0 * 33], s[1 * 33]); o.y = cvt_pk_bf16(s[2 * 33], s[3 * 33]); o.z = cvt_pk_bf16(s[4 * 33], s[5 * 33]); o.w = cvt_pk_bf16(s[6 * 33], s[7 * 33]);
        *(u32x4*)(WT + (size_t)(nrow0 + n) * K + k0 + 8 * c) = o; } }
    LDS_WAIT(); asm volatile("" ::: "memory");
}
__device__ __forceinline__ int win_src(int nb) {
    const int pn = nb >> 3, sub = nb & 7, bj = sub >> 2, hd = sub & 3, rp = 64 * hd + 32 * bj;
    if (pn < 4) return OFF_AQ + pn * 256 + rp;
    if (pn < 8) return OFF_AK + (pn - 4) * 256 + rp;
    if (pn < 12) return OFF_AV + (pn - 8) * 256 + sub * 32;
    if (pn < 14) return OFF_CQ + (pn - 12) * 256 + sub * 32;
    if (pn < 15) return OFF_CKV + sub * 32;
    if (pn < 19) return OFF_SWQ + (pn - 15) * 256 + rp;
    if (pn < 20) return OFF_SWK + rp;
    if (pn < 21) return OFF_SWV + sub * 32;
    if (pn < 45) return OFF_GATE + (pn - 21) * 256 + sub * 32;
    return hd == 0 ? OFF_KR + 32 * bj : -1;
}
__device__ __forceinline__ int wuq_src(int nb) {
    const int pn = nb >> 3, sub = nb & 7;
    if (pn < 4) return (2 * pn + (sub >> 2)) * 192 + 32 * (sub & 3);
    return (4 * (pn - 4) + (sub & 3)) * 192 + 128 + 32 * (sub >> 2);
}
__device__ __forceinline__ int wukv_src(int nb) {
    const int pn = nb >> 3, sub = nb & 7;
    if (pn < 4) return (2 * pn + (sub >> 2)) * 256 + 32 * (sub & 3);
    return (2 * (pn - 4) + (sub >> 2)) * 256 + 128 + 32 * (sub & 3);
}

constexpr int I_WIN = (F8P ? 16 : 32) * 184, I_WUQ = (F8U ? 4 : 8) * 24, I_WUKV = (F8U ? 2 : 4) * 32, I_WABC = 3 * (F8B ? 8 : 16) * 32, I_WO = (F8B ? 16 : 32) * 32, I_W13 = 16 * (F8M ? 16 : 32) * 16, I_W2 = 16 * (F8D ? 4 : 8) * 32;
constexpr int I_LAYER = I_WIN + I_WUQ + I_WUKV + I_WABC + I_WO + I_W13 + I_W2;
__device__ __forceinline__ void convert_item(const Ctx& X, KArgs a, int it, LAS float* scr) {
            const int l = it / I_LAYER; int r = it % I_LAYER;
            unsigned char* wb = X.ws + WS_W + (size_t)l * W_STRIDE;
            if (r < I_WIN) { const int nb = r % 184, kb = r / 184;
                cvt_item<F8P>((const float*)a->in[3] + (size_t)l * DM * IN_WIDTH, IN_WIDTH, win_src(2 * nb), win_src(2 * nb + 1), kb, (bf16_t*)(wb + WO_WIN), DM, nb * 64, nullptr, scr, X.lane); return; }
            r -= I_WIN;
            if (r < I_WUQ) { const int nb = r % 24, kb = r / 24;
                cvt_item<F8U>((const float*)a->in[9] + (size_t)l * 512 * 1536, 1536, wuq_src(2 * nb), wuq_src(2 * nb + 1), kb, (bf16_t*)(wb + WO_WUQ), 512, nb * 64, (const float*)a->in[7] + l * 512, scr, X.lane); return; }
            r -= I_WUQ;
            if (r < I_WUKV) { const int nb = r % 32, kb = r / 32;
                cvt_item<F8U>((const float*)a->in[10] + (size_t)l * 256 * 2048, 2048, wukv_src(2 * nb), wukv_src(2 * nb + 1), kb, (bf16_t*)(wb + WO_WUKV), 256, nb * 64, (const float*)a->in[8] + l * 256, scr, X.lane); return; }
            r -= I_WUKV;
            if (r < I_WABC) { constexpr int NKB = F8B ? 8 : 16; const int br = r / (NKB * 32), q = r % (NKB * 32), nb = q % 32, kb = q / 32;
                if constexpr (F8B) cvt_item<true>((const float*)a->in[12 + br] + (size_t)l * 1024 * 2048, 2048, nb * 64, nb * 64 + 32, kb, (bf16_t*)(wb + WO_WABC), 3072, nb * 64, nullptr, scr, X.lane, br * 1024);
                else cvt_item<false>((const float*)a->in[12 + br] + (size_t)l * 1024 * 2048, 2048, nb * 64, nb * 64 + 32, kb, (bf16_t*)(wb + WO_WABC) + (size_t)br * 2048 * 1024, 1024, nb * 64, nullptr, scr, X.lane);
                return; }
            r -= I_WABC;
            if (r < I_WO) { const int nb = r % 32, kb = r / 32;
                cvt_item<F8B>((const float*)a->in[15] + (size_t)l * 2048 * 2048, 2048, nb * 64, nb * 64 + 32, kb, (bf16_t*)(wb + WO_WO), 2048, nb * 64, nullptr, scr, X.lane); return; }
            r -= I_WO;
            if (r < I_W13) { constexpr int NKB = F8M ? 16 : 32; const int e = r / (NKB * 16), q = r % (NKB * 16), nb = q % 16, kb = q / 16;
                const int g0 = 2 * nb, pn = g0 >> 3, bj = (g0 & 7) >> 2, col = 128 * pn + 32 * (g0 & 3);
                const float* src = (const float*)a->in[bj ? 25 : 24] + ((size_t)l * NEXP + e) * DM * EH;
                bf16_t* dst = F8M ? (bf16_t*)((unsigned char*)(wb + WO_W13) + (size_t)e * 1024 * DM) : (bf16_t*)(wb + WO_W13) + (size_t)e * 1024 * DM;
                cvt_item<F8M>(src, EH, col, col + 32, kb, dst, DM, nb * 64, nullptr, scr, X.lane); return; }
            r -= I_W13;
            { constexpr int NKB = F8D ? 4 : 8; const int e = r / (NKB * 32), q = r % (NKB * 32), nb = q % 32, kb = q / 32;
                bf16_t* dst = F8D ? (bf16_t*)((unsigned char*)(wb + WO_W2) + (size_t)e * DM * EH) : (bf16_t*)(wb + WO_W2) + (size_t)e * DM * EH;
                cvt_item<F8D>((const float*)a->in[26] + ((size_t)l * NEXP + e) * EH * DM, DM, nb * 64, nb * 64 + 32, kb, dst, EH, nb * 64, nullptr, scr, X.lane); }
}
constexpr int D0_ABC0 = I_WIN + I_WUQ + I_WUKV, D0_ABC1 = D0_ABC0 + I_WABC, D0_WOA = D0_ABC1 + 320;
constexpr int D_WIN0 = I_LAYER, D_WIN1 = D_WIN0 + I_WIN, D_UQ1 = D_WIN1 + I_WUQ + I_WUKV, D_ABC1 = D_UQ1 + I_WABC, D_WO1 = D_ABC1 + I_WO, D_W20 = D_WO1 + I_W13, D_W21 = D_W20 + I_W2;
constexpr int D_W13A = D_WO1 + 320, D_W13B = D_WO1 + 560;
__device__ __forceinline__ bool item_deferred(int it) { return (it >= D0_ABC0 && it < D0_WOA) || (it >= D_WIN0 && it < D_W13B) || (it >= D_W20 && it < D_W21); }
__device__ __forceinline__ void convert_range(const Ctx& X, KArgs a, int it0, int it1, int gwi, int niw) {
    __syncthreads();
    LAS float* scr = (LAS float*)(X.lds + X.wave * 16640);
    for (int it = it0 + gwi; it < it1; it += niw) convert_item(X, a, it, scr);
}
__device__ __forceinline__ void phase_prologue(const Ctx& X, KArgs a) {
    const float* c_in = (const float*)a->in[1]; const int* pos = (const int*)a->in[2];
    const float* w_ada = (const float*)a->in[16]; const float* b_ada = (const float*)a->in[17];
    float* MOD = (float*)(X.ws + WS_MOD); float* COS = (float*)(X.ws + WS_COS); float* SIN = (float*)(X.ws + WS_SIN);
    {
        LAS float* cact = (LAS float*)(X.lds + 73728);
        LAS float* part = (LAS float*)(X.lds + 73728 + 16384);
        for (int i = X.tid; i < 2 * DM; i += 512) { const float v = c_in[i]; cact[i] = v * sigmoidf_(v); }
        __syncthreads();
        for (int it = blockIdx.x; it < 2 * 128; it += X.G) {
            const int l = it >> 7, cg = it & 127, kgp = X.tid / 24, l24 = X.tid % 24;
            if (X.tid < 504) {
                const float* wp = w_ada + (size_t)l * DM * 12288 + cg * 96 + l24 * 4;
                f32x4 a0 = {0.f, 0.f, 0.f, 0.f}, a1 = {0.f, 0.f, 0.f, 0.f};
#pragma unroll 20
                for (int k = kgp; k < DM; k += 21) { const f32x4 w = __builtin_nontemporal_load((const f32x4*)(wp + (size_t)k * 12288)); a0 += w * cact[k]; a1 += w * cact[DM + k]; }
                *(LAS f32x4*)(part + (kgp * 2 + 0) * 96 + l24 * 4) = a0; *(LAS f32x4*)(part + (kgp * 2 + 1) * 96 + l24 * 4) = a1; }
            __syncthreads();
            if (X.tid < 192) { const int b = X.tid / 96, cc = X.tid % 96; float s = 0.f;
#pragma unroll
                for (int g = 0; g < 21; ++g) s += part[(g * 2 + b) * 96 + cc];
                MOD[(size_t)(l * 2 + b) * 12288 + cg * 96 + cc] = s + b_ada[l * 12288 + cg * 96 + cc]; }
            __syncthreads();
        }
    }
    for (int i = blockIdx.x * 512 + X.tid; i < T * 32; i += X.G * 512) {
        const int t = i >> 5, f = i & 31; const float p = (float)pos[t];
        const double invd = exp2(-(double)f * (13.287712379549449 / 32.0)) * 0.15915494309189535;
        const float ih = (float)invd, il = (float)(invd - (double)ih);
        const float ph = p * ih, pe = fmaf(p, ih, -ph);
        float fr = (ph - rintf(ph)) + (pe + p * il);
        fr = fr - rintf(fr);
        COS[i] = __builtin_amdgcn_cosf(fr); SIN[i] = __builtin_amdgcn_sinf(fr);
    }
    {
        LAS float* scr = (LAS float*)(X.lds + X.wave * 16640);
        for (int it = X.gw; it < DEPTH * I_LAYER; it += X.NGW) if (!item_deferred(it)) convert_item(X, a, it, scr);
    }
}

__device__ __forceinline__ void row_stats(const f32x4 (&v)[8], float& mean, float& rstd) {
    float s = 0.f;
#pragma unroll
    for (int j = 0; j < 8; ++j) s += (v[j][0] + v[j][1]) + (v[j][2] + v[j][3]);
    mean = wave_sum(s) * (1.0f / DM); float q = 0.f;
#pragma unroll
    for (int j = 0; j < 8; ++j) { const f32x4 d = v[j] - mean; q += (d[0] * d[0] + d[1] * d[1]) + (d[2] * d[2] + d[3] * d[3]); }
    rstd = 1.0f / sqrtf(wave_sum(q) * (1.0f / DM) + LN_EPS);
}
__device__ __forceinline__ void modulate_store(f32x4 (&v)[8], const float* sh, const float* sc, unsigned char* hrow, int lane) {
    float mean, rstd; row_stats(v, mean, rstd);
#pragma unroll
    for (int j = 0; j < 8; ++j) { const int c = 256 * j + 4 * lane; const f32x4 a = *(const f32x4*)(sc + c), b = *(const f32x4*)(sh + c);
        v[j] = (v[j] - mean) * rstd * (a + 1.0f) + b;
        if constexpr (F8P) *(unsigned*)(hrow + c) = pack4_fp8(v[j][0], v[j][1], v[j][2], v[j][3]);
        else { u32x2 w; w.x = cvt_pk_bf16(v[j][0], v[j][1]); w.y = cvt_pk_bf16(v[j][2], v[j][3]); *(u32x2*)(hrow + 2 * c) = w; } }
}
__device__ __forceinline__ void phase_ln1(const Ctx& X, const float* xin, int l) {
    const float* MOD = (const float*)(X.ws + WS_MOD); unsigned char* H = X.ws + WS_H;
    int gw_ = X.gw; asm volatile("" : "+s"(gw_));
    f32x4 vn[8];
#pragma unroll
    for (int j = 0; j < 8; ++j) vn[j] = __builtin_nontemporal_load((const f32x4*)(xin + (size_t)gw_ * DM + 256 * j + 4 * X.lane));
    f32x4 v[8];
#pragma unroll
    for (int j = 0; j < 8; ++j) v[j] = vn[j];
    for (int t = gw_; t < T; t += X.NGW) { const int b = t >> 12; f32x4 pg[8], pb[8];
        const float* mb = MOD + (size_t)(l * 2 + b) * 12288;
#pragma unroll
        for (int j = 0; j < 8; ++j) { const int c = 256 * j + 4 * X.lane; pg[j] = *(const f32x4*)(mb + 1 * DM + c); pb[j] = *(const f32x4*)(mb + 0 * DM + c); }
        asm volatile("" ::: "memory");
        if (t + X.NGW < T) {
#pragma unroll
            for (int j = 0; j < 8; ++j) vn[j] = __builtin_nontemporal_load((const f32x4*)(xin + (size_t)(t + X.NGW) * DM + 256 * j + 4 * X.lane)); }
        asm volatile("" ::: "memory");
        { bf16_t* xc = (bf16_t*)(X.ws + WS_XCUR) + (size_t)t * DM;
#pragma unroll
          for (int j = 0; j < 8; ++j) *(u32x2*)(xc + 256 * j + 4 * X.lane) = pk_bf4(v[j]); }
        float mean, rstd; row_stats(v, mean, rstd); unsigned char* hrow = H + (size_t)t * HROWB;
#pragma unroll
        for (int j = 0; j < 8; ++j) { const int c = 256 * j + 4 * X.lane;
            v[j] = (v[j] - mean) * rstd * (pg[j] + 1.0f) + pb[j];
            if constexpr (F8P) *(unsigned*)(hrow + c) = pack4_fp8(v[j][0], v[j][1], v[j][2], v[j][3]);
            else { u32x2 w; w.x = cvt_pk_bf16(v[j][0], v[j][1]); w.y = cvt_pk_bf16(v[j][2], v[j][3]); *(u32x2*)(hrow + 2 * c) = w; } }
        asm volatile("" ::: "memory");
        if (t + X.NGW < T) {
#pragma unroll
            for (int j = 0; j < 8; ++j) v[j] = vn[j]; } }
}
__device__ __forceinline__ void phase_ln2_route(const Ctx& X, KArgs a, int l) {
    const float* MOD = (const float*)(X.ws + WS_MOD); unsigned char* H = X.ws + WS_H; const bf16_t* U = (const bf16_t*)(X.ws + WS_U); bf16_t* XC = (bf16_t*)(X.ws + WS_XCUR);
    const float* lg = (const float*)a->in[18] + l * DM; const float* lb = (const float*)a->in[19] + l * DM;
    const float* rw = (const float*)a->in[22]; const float* rbias = (const float*)a->in[23];
    int* ROUTE = (int*)(X.ws + WS_ROUTE);
    LAS float* RWT = (LAS float*)X.lds;
    u32x2 vn[8];
#pragma unroll
    for (int j = 0; j < 8; ++j) vn[j] = *(const u32x2*)(U + (size_t)X.gw * DM + 256 * j + 4 * X.lane);
    {
        f32x4 rv[16];
#pragma unroll
        for (int j = 0; j < 16; ++j) rv[j] = ((const f32x4*)rw)[X.tid + 512 * j];
#pragma unroll
        for (int j = 0; j < 16; ++j) { const int i4 = X.tid + 512 * j, e0 = 4 * (i4 & 3), k = i4 >> 2;
#pragma unroll
            for (int c = 0; c < 4; ++c) RWT[(e0 + c) * DM + k] = rv[j][c]; }
    }
    __syncthreads();
    float bias[16];
#pragma unroll
    for (int e = 0; e < 16; ++e) bias[e] = rbias[e];
    f32x4 v[8];
#pragma unroll
    for (int j = 0; j < 8; ++j) v[j] = up_bf4(vn[j]);
    for (int t = X.gw; t < T; t += X.NGW) { const int b = t >> 12; f32x4 pg[8], pb[8];
        const float* mb = MOD + (size_t)(l * 2 + b) * 12288;
#pragma unroll
        for (int j = 0; j < 8; ++j) { const int c = 256 * j + 4 * X.lane; pg[j] = *(const f32x4*)(lg + c); pb[j] = *(const f32x4*)(lb + c); }
        asm volatile("" ::: "memory");
        if (t + X.NGW < T) {
#pragma unroll
            for (int j = 0; j < 8; ++j) vn[j] = *(const u32x2*)(U + (size_t)(t + X.NGW) * DM + 256 * j + 4 * X.lane); }
        asm volatile("" ::: "memory");
        float mean, rstd; row_stats(v, mean, rstd);
#pragma unroll
        for (int j = 0; j < 8; ++j) v[j] = (v[j] - mean) * rstd * pg[j] + pb[j];
#pragma unroll
        for (int j = 0; j < 8; ++j) { const int c = 256 * j + 4 * X.lane; pg[j] = *(const f32x4*)(mb + 4 * DM + c); pb[j] = *(const f32x4*)(mb + 3 * DM + c); }
        asm volatile("" ::: "memory");
#pragma unroll
        for (int j = 0; j < 8; ++j) *(u32x2*)(XC + (size_t)t * DM + 256 * j + 4 * X.lane) = pk_bf4(v[j]);
        asm volatile("" ::: "memory");
        row_stats(v, mean, rstd);
        { unsigned char* hrow = H + (size_t)t * HROWB;
#pragma unroll
          for (int j = 0; j < 8; ++j) { const int c = 256 * j + 4 * X.lane;
            v[j] = (v[j] - mean) * rstd * (pg[j] + 1.0f) + pb[j];
            if constexpr (F8P) *(unsigned*)(hrow + c) = pack4_fp8(v[j][0], v[j][1], v[j][2], v[j][3]);
            else { u32x2 w; w.x = cvt_pk_bf16(v[j][0], v[j][1]); w.y = cvt_pk_bf16(v[j][2], v[j][3]); *(u32x2*)(hrow + 2 * c) = w; } } }
        asm volatile("" ::: "memory");
        float sc[16];
        { f32x4 w[8];
#pragma unroll
          for (int j = 0; j < 8; ++j) w[j] = *(const LAS f32x4*)(RWT + 256 * j + 4 * X.lane);
#pragma unroll
          for (int e = 0; e < 16; ++e) { f32x4 wn[8];
            if (e < 15) {
#pragma unroll
                for (int j = 0; j < 8; ++j) wn[j] = *(const LAS f32x4*)(RWT + (e + 1) * DM + 256 * j + 4 * X.lane); }
            asm volatile("" ::: "memory");
            float s = 0.f;
#pragma unroll
            for (int j = 0; j < 8; ++j) s += (v[j][0] * w[j][0] + v[j][1] * w[j][1]) + (v[j][2] * w[j][2] + v[j][3] * w[j][3]);
            sc[e] = wave_sum(s);
            if (e < 15) {
#pragma unroll
                for (int j = 0; j < 8; ++j) w[j] = wn[j]; } } }
#pragma unroll
        for (int e = 0; e < 16; ++e) sc[e] = sigmoidf_(sc[e]);
        float gs[4]; int i0[4], i1[4];
#pragma unroll
        for (int g = 0; g < 4; ++g) { const float b0 = sc[4 * g] + bias[4 * g], b1 = sc[4 * g + 1] + bias[4 * g + 1], b2 = sc[4 * g + 2] + bias[4 * g + 2], b3 = sc[4 * g + 3] + bias[4 * g + 3];
            float m0 = b0; int a0 = 0; if (b1 > m0) { m0 = b1; a0 = 1; } if (b2 > m0) { m0 = b2; a0 = 2; } if (b3 > m0) { m0 = b3; a0 = 3; }
            float m1 = -3e38f; int a1 = 0;
            if (a0 != 0 && b0 > m1) { m1 = b0; a1 = 0; } if (a0 != 1 && b1 > m1) { m1 = b1; a1 = 1; } if (a0 != 2 && b2 > m1) { m1 = b2; a1 = 2; } if (a0 != 3 && b3 > m1) { m1 = b3; a1 = 3; }
            gs[g] = m0 + m1; i0[g] = 4 * g + a0; i1[g] = 4 * g + a1; }
        int best = 0; float bg = gs[0];
#pragma unroll
        for (int g = 1; g < 4; ++g) if (gs[g] > bg) { bg = gs[g]; best = g; }
        int e0 = i0[0], e1 = i1[0];
#pragma unroll
        for (int g = 1; g < 4; ++g) if (best == g) { e0 = i0[g]; e1 = i1[g]; }
        float w0 = 0.f, w1 = 0.f;
#pragma unroll
        for (int e = 0; e < 16; ++e) { if (e0 == e) w0 = sc[e]; if (e1 == e) w1 = sc[e]; }
        const float inv = 1.0f / (w0 + w1); w0 *= inv; w1 *= inv;
        if (X.lane == 0) { int* rp = ROUTE + (size_t)t * 8; rp[0] = e0; rp[2] = e1; rp[4] = __float_as_int(w0); rp[5] = __float_as_int(w1); ((int*)(X.ws + WS_RT8))[t] = e0 | (e1 << 8); }
        asm volatile("" ::: "memory");
        if (t + X.NGW < T) {
#pragma unroll
            for (int j = 0; j < 8; ++j) v[j] = up_bf4(vn[j]); }
    }
    __syncthreads();
}
__device__ __forceinline__ int build_expert_tables(const Ctx& X, int l, const LAS int* lcnt = nullptr) {
    const int* CNT = (const int*)(X.ws + WS_CTL) + CW_CNT + 64 * l;
    LAS int* base = (LAS int*)(X.lds + L_BASE); LAS int* tab = (LAS int*)(X.lds + L_TILEEXP);
    LAS int* gcnt = (LAS int*)(X.lds + L_BASE) + 48;
    __syncthreads();
    if (!lcnt) { if (X.tid < 16) gcnt[X.tid] = __hip_atomic_load(CNT + X.tid, __ATOMIC_RELAXED, __HIP_MEMORY_SCOPE_AGENT); __syncthreads(); lcnt = gcnt; }
    if (X.tid < 128) { int p = 0, mine = -1; const int row = X.tid * 256;
        for (int e = 0; e < 16; ++e) { const int c = lcnt[e]; const int pe = (c + 255) & ~255;
            if (X.tid == e) { base[e] = p; base[32 + e] = c; } if (row >= p && row < p + pe) mine = e; p += pe; }
        if (X.tid == 16) base[16] = p;
        tab[X.tid] = mine < 0 ? 0 : mine; }
    __syncthreads();
    int total = base[16]; if (total > MAXROWS) total = MAXROWS;
    return total >> 8;
}
__device__ __forceinline__ int moe_prepare(const Ctx& X, int l) {
    typedef unsigned long long u64_;
    LAS u64_* bm = (LAS u64_*)X.lds;
    LAS int* pre = (LAS int*)(X.lds + 16384);
    LAS int* ctot = (LAS int*)(X.lds + 24576);
    LAS int* cntl = (LAS int*)(X.lds + 26624);
    LAS int* rowtok = (LAS int*)(X.lds + L_ROWTOK); LAS float* rowgw = (LAS float*)(X.lds + L_ROWGW);
    const int* ROUTE = (const int*)(X.ws + WS_ROUTE); int* ROWIDX = (int*)(X.ws + WS_ROWIDX);
    __syncthreads();
    int rt[16]; u32x2 gwt[16];
    { const int* RT8 = (const int*)(X.ws + WS_RT8);
#pragma unroll
      for (int i = 0; i < 16; ++i) { const int t = 64 * (i * 8 + X.wave) + X.lane; rt[i] = RT8[t]; gwt[i] = *(const u32x2*)(ROUTE + (size_t)t * 8 + 4); }
      rowtok[X.tid] = 0; rowgw[X.tid] = 0.f;
#pragma unroll
      for (int i = 0; i < 16; ++i) { const int w = i * 8 + X.wave, e0 = rt[i] & 255, e1 = rt[i] >> 8; u64_ mine = 0;
#pragma unroll
        for (int e = 0; e < 16; ++e) { const u64_ m = __ballot(e0 == e || e1 == e); mine = (X.lane == e) ? m : mine; }
        if (X.lane < 16) bm[X.lane * 128 + w] = mine; } }
    __syncthreads();
    { const int e = X.tid >> 5, j = X.tid & 31; int c[4], sum = 0;
#pragma unroll
      for (int k = 0; k < 4; ++k) { c[k] = __popcll(bm[e * 128 + 4 * j + k]); sum += c[k]; }
      ctot[e * 32 + j] = sum;
      __syncthreads();
      int off = 0;
      for (int q = 0; q < 32; ++q) { const int v = ctot[e * 32 + q]; off += (q < j) ? v : 0; }
      pre[e * 128 + 4 * j] = off; pre[e * 128 + 4 * j + 1] = off + c[0]; pre[e * 128 + 4 * j + 2] = off + c[0] + c[1]; pre[e * 128 + 4 * j + 3] = off + c[0] + c[1] + c[2];
      if (j == 31) cntl[e] = off + sum; }
    __syncthreads();
    if (blockIdx.x == 0 && X.tid < 16) ((int*)(X.ws + WS_CTL) + CW_CNT + 64 * l)[X.tid] = cntl[X.tid];
    const int nrt = build_expert_tables(X, l, cntl);
    const LAS int* base = (const LAS int*)(X.lds + L_BASE);
    const int c = (int)blockIdx.x, nun = nrt * 4, pm0 = (c < nun) ? c / 4 : -1, pm1 = (c + X.G < nun) ? (c + X.G) / 4 : -1;
#pragma unroll
    for (int i = 0; i < 16; ++i) { const int tw = i * 8 + X.wave, t = 64 * tw + X.lane; const u64_ lowm = (1ull << X.lane) - 1ull;
        const bool own = ((X.G & (X.G - 1)) == 0) ? ((t & (X.G - 1)) == c) : ((t % X.G) == c);
#pragma unroll
        for (int k = 0; k < 2; ++k) { const int e = k ? (rt[i] >> 8) : (rt[i] & 255);
            const int slot = base[e] + pre[e * 128 + tw] + __popcll(bm[e * 128 + tw] & lowm), pm = slot >> 8;
            if (pm == pm0 || pm == pm1) { const int idx = (pm == pm0 ? 0 : 256) + (slot & 255); rowtok[idx] = t; rowgw[idx] = __uint_as_float(k ? gwt[i].y : gwt[i].x); }
            if (own) ROWIDX[2 * t + k] = slot; } }
    __syncthreads();
    return nrt;
}
template <bool HNEXT>
__device__ __forceinline__ void phase_final(const Ctx& X, KArgs a, int l, float* out) {
    constexpr bool hnext = HNEXT;
    const float* MOD = (const float*)(X.ws + WS_MOD); unsigned char* H = X.ws + WS_H; const bf16_t* XC = (const bf16_t*)(X.ws + WS_XCUR);
    const bf16_t* OS = (const bf16_t*)(X.ws + WS_ARENA + AR_OS); const int* ROWIDX = (const int*)(X.ws + WS_ROWIDX);
    constexpr int NIT = T / (256 * 8); static_assert(NIT == 4, "four rows per wave");
    int rr0[NIT], rr1[NIT];
#pragma unroll
    for (int i = 0; i < NIT; ++i) { const int t = X.gw + i * X.NGW; rr0[i] = ROWIDX[2 * t]; rr1[i] = ROWIDX[2 * t + 1]; }
    u32x2 xn[8], pn[8], qn[8];
    { const int t = X.gw;
#pragma unroll
      for (int j = 0; j < 8; ++j) { const int c = 256 * j + 4 * X.lane; xn[j] = *(const u32x2*)(XC + (size_t)t * DM + c); pn[j] = *(const u32x2*)(OS + (size_t)rr0[0] * DM + c); qn[j] = *(const u32x2*)(OS + (size_t)rr1[0] * DM + c); } }
    LAS float* PL = (LAS float*)X.lds;
    { const float* srcs[8] = {(const float*)a->in[20] + l * DM, (const float*)a->in[21] + l * DM, MOD + (size_t)(l * 2 + 0) * 12288 + 5 * DM, MOD + (size_t)(l * 2 + 1) * 12288 + 5 * DM,
                              MOD + (size_t)((l + 1) * 2 + 0) * 12288 + 1 * DM, MOD + (size_t)((l + 1) * 2 + 1) * 12288 + 1 * DM, MOD + (size_t)((l + 1) * 2 + 0) * 12288, MOD + (size_t)((l + 1) * 2 + 1) * 12288};
      f32x4 pv[8];
#pragma unroll
      for (int k = 0; k < 8; ++k) pv[k] = (k < 4 || hnext) ? *(const f32x4*)(srcs[k] + 4 * X.tid) : (f32x4){0.f, 0.f, 0.f, 0.f};
#pragma unroll
      for (int k = 0; k < 8; ++k) *(LAS f32x4*)(PL + k * DM + 4 * X.tid) = pv[k]; }
    __syncthreads();
    f32x4 v[8];
#define FIN_COMBINE(bb) do { _Pragma("unroll") for (int j = 0; j < 8; ++j) { const f32x4 x = up_bf4(xn[j]), g = *(const LAS f32x4*)(PL + (2 + (bb)) * DM + 256 * j + 4 * X.lane); const u32x2 p = pn[j], q = qn[j]; \
        f32x4 y; y[0] = bflo(p.x) + bflo(q.x); y[1] = bfhi(p.x) + bfhi(q.x); y[2] = bflo(p.y) + bflo(q.y); y[3] = bfhi(p.y) + bfhi(q.y); v[j] = x * ALPHA + g * y; } } while (0)
    FIN_COMBINE(X.gw >> 12);
#pragma unroll 1
    for (int i = 0; i < NIT; ++i) { const int t = X.gw + i * X.NGW, b = t >> 12;
        if (i + 1 < NIT) { const int tn = t + X.NGW;
            const int rn0 = (i == 0) ? rr0[1] : (i == 1) ? rr0[2] : rr0[3], rn1 = (i == 0) ? rr1[1] : (i == 1) ? rr1[2] : rr1[3];
#pragma unroll
            for (int j = 0; j < 8; ++j) { const int c = 256 * j + 4 * X.lane; xn[j] = *(const u32x2*)(XC + (size_t)tn * DM + c); pn[j] = *(const u32x2*)(OS + (size_t)rn0 * DM + c); qn[j] = *(const u32x2*)(OS + (size_t)rn1 * DM + c); } }
        asm volatile("" ::: "memory");
        float mean, rstd; row_stats(v, mean, rstd);
#pragma unroll
        for (int j = 0; j < 8; ++j) { const int c = 256 * j + 4 * X.lane; v[j] = (v[j] - mean) * rstd * *(const LAS f32x4*)(PL + c) + *(const LAS f32x4*)(PL + DM + c);
            if (hnext) *(u32x2*)((bf16_t*)out + (size_t)t * DM + c) = pk_bf4(v[j]); else __builtin_nontemporal_store(v[j], (f32x4*)(out + (size_t)t * DM + c)); }
        if (hnext) { row_stats(v, mean, rstd); unsigned char* hrow = H + (size_t)t * HROWB;
#pragma unroll
            for (int j = 0; j < 8; ++j) { const int c = 256 * j + 4 * X.lane;
                v[j] = (v[j] - mean) * rstd * (*(const LAS f32x4*)(PL + (4 + b) * DM + c) + 1.0f) + *(const LAS f32x4*)(PL + (6 + b) * DM + c);
                if constexpr (F8P) *(unsigned*)(hrow + c) = pack4_fp8(v[j][0], v[j][1], v[j][2], v[j][3]);
                else { u32x2 w; w.x = cvt_pk_bf16(v[j][0], v[j][1]); w.y = cvt_pk_bf16(v[j][2], v[j][3]); *(u32x2*)(hrow + 2 * c) = w; } } }
        asm volatile("" ::: "memory");
        if (i + 1 < NIT) FIN_COMBINE((t + X.NGW) >> 12);
    }
#undef FIN_COMBINE
    __syncthreads();
}

__device__ __forceinline__ void phase_attention(const Ctx& X, KArgs a, int l) {
    unsigned char* ar = X.ws + WS_ARENA;
    const bf16_t *AQ = (const bf16_t*)(ar + AR_AQ), *AK = (const bf16_t*)(ar + AR_AK), *AV = (const bf16_t*)(ar + AR_AV);
    const bf16_t *QM = (const bf16_t*)(ar + AR_QM), *KM = (const bf16_t*)(ar + AR_KM), *VM = (const bf16_t*)(ar + AR_VM);
    const bf16_t *SWQ = (const bf16_t*)(ar + AR_SWQ), *SWK = (const bf16_t*)(ar + AR_SWK), *SWV = (const bf16_t*)(ar + AR_SWV);
    bf16_t *YA = (bf16_t*)(ar + AR_YABC), *YB = YA + (size_t)T * 1024, *YC = YB + (size_t)T * 1024;
    float* SCR = (float*)(ar + AR_SCR);
    const int tid_ = opaque_tid(X.wave), wid = __builtin_amdgcn_readfirstlane(tid_ >> 6), lane = tid_ & 63, r32 = lane & 31, hi = lane >> 5;
    char* lds = X.ldsg;
    const int c = blockIdx.x, xcd = c & 7, idx = c >> 3;
    if constexpr (PHEN(13)) REP(13) {
        constexpr float C = 0.125f * 1.4426950408889634f, THRR = 8.0f / 0.125f;
        const int per = X.G >> 3;
        for (int u = (X.G == 256) ? (xcd * per + idx) : c; u < 256; u += X.G) {
            const int bh = u >> 4, qb = u & 15, b = bh >> 3, h = bh & 7, q0 = qb * 256;
            f32x16 o[4]; float lsum; float rli[16]; f32x16 lrow;
            if constexpr (QK8A) { constexpr float C8 = C / (S_QK * S_QK);
                att::attn_body_dma<64, 128, false, true, true>((const bf16_t*)((const unsigned char*)AQ + ((size_t)((b * 2 + 0) * 8 + h) * SEQ + q0 + wid * 32) * 64), 64, (const bf16_t*)((const unsigned char*)AK + (size_t)((b * 2 + 0) * 8 + h) * SEQ * 64), 64,
                                               (const bf16_t*)((const unsigned char*)AV + (size_t)(b * 8 + h) * 128 * SEQ), SEQ, SEQ / 64, C8, PV8_THR / C8, -1e30f, 0.f, 0, lds, o, lsum, X.wave, &lrow);
#pragma unroll
                for (int r = 0; r < 16; ++r) rli[r] = __builtin_amdgcn_rcpf(lrow[r]) * (1.0f / S_V); }
            else if constexpr (PV8A) { att::attn_body_dma<64, 128, false, true>(AQ + ((size_t)((b * 2 + 0) * 8 + h) * SEQ + q0 + wid * 32) * 64, 64, AK + (size_t)((b * 2 + 0) * 8 + h) * SEQ * 64, 64,
                                               (const bf16_t*)((const unsigned char*)AV + (size_t)(b * 8 + h) * 128 * SEQ), SEQ, SEQ / 64, C, PV8_THR / C, -1e30f, 0.f, 0, lds, o, lsum, X.wave, &lrow);
#pragma unroll
                for (int r = 0; r < 16; ++r) rli[r] = __builtin_amdgcn_rcpf(lrow[r]) * (1.0f / S_V); }
            else { att::attn_body_dma<64, 128, false>(AQ + ((size_t)((b * 2 + 0) * 8 + h) * SEQ + q0 + wid * 32) * 64, 64, AK + (size_t)((b * 2 + 0) * 8 + h) * SEQ * 64, 64,
                                               AV + (size_t)(b * 8 + h) * SEQ * 128, 128, SEQ / 64, C, THRR, -1e30f, 0.f, 0, lds, o, lsum, X.wave);
                att::row_rcp(lsum, lds, 3 * (64 * 128 * 2 + 64 * 64 * 2), rli, X.wave); }
            GAS f32x4* scr = opaque_ptr((f32x4*)(SCR + ((size_t)(blockIdx.x * 8 + wid) * 64 + lane) * 64));
#pragma unroll
            for (int d = 0; d < 4; ++d)
#pragma unroll
                for (int q = 0; q < 4; ++q) scr[d * 4 + q] = (f32x4){o[d][4 * q] * rli[4 * q], o[d][4 * q + 1] * rli[4 * q + 1], o[d][4 * q + 2] * rli[4 * q + 2], o[d][4 * q + 3] * rli[4 * q + 3]};
            if constexpr (QK8A) { constexpr float C8 = C / (S_QK * S_QK);
                att::attn_body_dma<64, 128, false, true, true>((const bf16_t*)((const unsigned char*)AQ + ((size_t)((b * 2 + 1) * 8 + h) * SEQ + q0 + wid * 32) * 64), 64, (const bf16_t*)((const unsigned char*)AK + (size_t)((b * 2 + 1) * 8 + h) * SEQ * 64), 64,
                                               (const bf16_t*)((const unsigned char*)AV + (size_t)(b * 8 + h) * 128 * SEQ), SEQ, SEQ / 64, C8, PV8_THR / C8, -1e30f, 0.f, 0, lds, o, lsum, X.wave, &lrow);
#pragma unroll
                for (int r = 0; r < 16; ++r) rli[r] = __builtin_amdgcn_rcpf(lrow[r]) * (1.0f / S_V); }
            else if constexpr (PV8A) { att::attn_body_dma<64, 128, false, true>(AQ + ((size_t)((b * 2 + 1) * 8 + h) * SEQ + q0 + wid * 32) * 64, 64, AK + (size_t)((b * 2 + 1) * 8 + h) * SEQ * 64, 64,
                                               (const bf16_t*)((const unsigned char*)AV + (size_t)(b * 8 + h) * 128 * SEQ), SEQ, SEQ / 64, C, PV8_THR / C, -1e30f, 0.f, 0, lds, o, lsum, X.wave, &lrow);
#pragma unroll
                for (int r = 0; r < 16; ++r) rli[r] = __builtin_amdgcn_rcpf(lrow[r]) * (1.0f / S_V); }
            else { att::attn_body_dma<64, 128, false>(AQ + ((size_t)((b * 2 + 1) * 8 + h) * SEQ + q0 + wid * 32) * 64, 64, AK + (size_t)((b * 2 + 1) * 8 + h) * SEQ * 64, 64,
                                               AV + (size_t)(b * 8 + h) * SEQ * 128, 128, SEQ / 64, C, THRR, -1e30f, 0.f, 0, lds, o, lsum, X.wave);
                att::row_rcp(lsum, lds, 3 * (64 * 128 * 2 + 64 * 64 * 2), rli, X.wave); }
            asm volatile("s_waitcnt vmcnt(0)" ::: "memory");
            const float lam_init = (l == 0) ? 0.2f : 0.35550906759096f;
            const GAS float* lq = opaque_ptr((const float*)a->in[4] + l * 128); const float* lk = (const float*)a->in[5] + l * 128;
            const float e0 = __expf(wave_sum(lq[lane] * lk[lane])), e1 = __expf(wave_sum(lq[64 + lane] * lk[64 + lane]));
            const float lam = e0 - e1 + lam_init;
            const GAS float* sg = opaque_ptr((const float*)a->in[6] + l * 128);
            float sub[4];
#pragma unroll
            for (int d = 0; d < 4; ++d) sub[d] = sg[32 * d + r32] * (1.0f - lam_init);
            const GAS f32x4* scr2 = opaque_ptr((const f32x4*)(SCR + ((size_t)(blockIdx.x * 8 + wid) * 64 + lane) * 64));
#pragma unroll
            for (int d = 0; d < 4; ++d)
#pragma unroll
                for (int q = 0; q < 4; ++q) { const f32x4 o1 = scr2[d * 4 + q];
#pragma unroll
                    for (int j = 0; j < 4; ++j) o[d][4 * q + j] = o1[j] - lam * (o[d][4 * q + j] * rli[4 * q + j]); }
            GAS bf16_t* ybase = opaque_ptr(YA + (size_t)(b * SEQ + q0 + wid * 32 + 4 * hi) * 1024 + h * 128 + r32);
            GAS unsigned char* y8base = opaque_ptr((unsigned char*)YA + (size_t)(b * SEQ + q0 + wid * 32 + 4 * hi) * 3072 + 0 * 1024 + h * 128 + r32);
#pragma unroll
            for (int r = 0; r < 16; ++r) { float ss = (o[0][r] * o[0][r] + o[1][r] * o[1][r]) + (o[2][r] * o[2][r] + o[3][r] * o[3][r]);
                ss = xor16_sum(row16_sum(ss));
                const float rs = 1.0f / sqrtf(ss * (1.0f / 128.0f) + RMS_EPS);
                GAS bf16_t* yp = ybase + (size_t)((r & 3) + 8 * (r >> 2)) * 1024; GAS unsigned char* yp8 = y8base + (size_t)((r & 3) + 8 * (r >> 2)) * 3072;
#pragma unroll
                for (int d = 0; d < 4; ++d) { if constexpr (F8B) yp8[32 * d] = fp8_byte(o[d][r] * rs * sub[d] * S_YA); else yp[32 * d] = (bf16_t)(cvt_pk_bf16(o[d][r] * rs * sub[d], 0.f) & 0xffffu); } }
        }
    }
    if constexpr (PHEN(14)) REP(14) {
        constexpr float SC = 0.07216878364870322f, C = SC * 1.4426950408889634f, THRR = 8.0f / SC;
        const int per = X.G >> 3;
        for (int u = (X.G == 256) ? (xcd * per + idx) : c; u < 256; u += X.G) {
            const int bh = u >> 4, qb = u & 15, b = bh >> 3, h = bh & 7, q0 = qb * 256;
            f32x16 o[4]; float lsum; float rli[16]; f32x16 lrow;
            if constexpr (QK8B) { constexpr float C8 = C / (S_QK * S_QK);
                att::attn_body_dma<192, 128, false, true, true>((const bf16_t*)((const unsigned char*)QM + ((size_t)bh * SEQ + q0 + wid * 32) * 192), 192, (const bf16_t*)((const unsigned char*)KM + (size_t)bh * SEQ * 192), 192,
                                                (const bf16_t*)((const unsigned char*)VM + (size_t)bh * 128 * SEQ), SEQ, SEQ / 64, C8, PV8_THR / C8, -1e30f, 0.f, 0, lds, o, lsum, X.wave, &lrow);
#pragma unroll
                for (int r = 0; r < 16; ++r) rli[r] = __builtin_amdgcn_rcpf(lrow[r]) * (1.0f / S_V); }
            else if constexpr (PV8B) { att::attn_body_dma<192, 128, false, true>(QM + ((size_t)bh * SEQ + q0 + wid * 32) * 192, 192, KM + (size_t)bh * SEQ * 192, 192,
                                                (const bf16_t*)((const unsigned char*)VM + (size_t)bh * 128 * SEQ), SEQ, SEQ / 64, C, PV8_THR / C, -1e30f, 0.f, 0, lds, o, lsum, X.wave, &lrow);
#pragma unroll
                for (int r = 0; r < 16; ++r) rli[r] = __builtin_amdgcn_rcpf(lrow[r]) * (1.0f / S_V); }
            else { att::attn_body_dma<192, 128, false>(QM + ((size_t)bh * SEQ + q0 + wid * 32) * 192, 192, KM + (size_t)bh * SEQ * 192, 192, VM + (size_t)bh * SEQ * 128, 128, SEQ / 64,
                                                C, THRR, -1e30f, 0.f, 0, lds, o, lsum, X.wave);
                att::row_rcp(lsum, lds, 3 * (64 * 128 * 2 + 64 * 192 * 2), rli, X.wave); }
            GAS bf16_t* ybase = opaque_ptr(YB + (size_t)(b * SEQ + q0 + wid * 32 + 4 * hi) * 1024 + h * 128 + r32);
            GAS unsigned char* y8base = opaque_ptr((unsigned char*)YA + (size_t)(b * SEQ + q0 + wid * 32 + 4 * hi) * 3072 + 1 * 1024 + h * 128 + r32);
#pragma unroll
            for (int r = 0; r < 16; ++r) { GAS bf16_t* yp = ybase + (size_t)((r & 3) + 8 * (r >> 2)) * 1024; GAS unsigned char* yp8 = y8base + (size_t)((r & 3) + 8 * (r >> 2)) * 3072;
#pragma unroll
                for (int d = 0; d < 4; ++d) { if constexpr (F8B) yp8[32 * d] = fp8_byte(o[d][r] * rli[r] * S_YB); else yp[32 * d] = (bf16_t)(cvt_pk_bf16(o[d][r] * rli[r], 0.f) & 0xffffu); } }
        }
    }
    if constexpr (PHEN(15)) REP(15) {
        constexpr float SC = 0.125f, C = SC * 1.4426950408889634f, THRR = 8.0f / SC;
        const float* sink = (const float*)a->in[11] + l * 16;
        for (int u = c; u < 512; u += X.G) {
            const int pr = u & 1, qblk = (u >> 1) & 31, kvh = (u >> 6) & 3, b = u >> 8;
            const int hq = kvh * 4 + 2 * pr + (wid >> 2), q0 = qblk * 128;
            const int key0 = (q0 - 128 < 0) ? 0 : q0 - 128, key1 = (q0 + 256 > SEQ) ? SEQ : q0 + 256, NT = (key1 - key0) >> 6;
            const int qw = q0 + (wid & 3) * 32;
            f32x16 o[2]; float lsum; float rli[16];
            if constexpr (PV8C) { constexpr float C8 = C / (S_QK * S_QK); f32x16 lrow;
                att::attn_body_dma<64, 64, true, true, true>((const bf16_t*)((const unsigned char*)SWQ + ((size_t)(b * 16 + hq) * SEQ + qw) * 64), 64, (const bf16_t*)((const unsigned char*)SWK + ((size_t)(b * 4 + kvh) * SEQ + key0) * 64), 64,
                                            (const bf16_t*)((const unsigned char*)SWV + (size_t)(b * 4 + kvh) * 64 * SEQ + key0), SEQ, NT, C8, PV8_THR / C8, sink[hq] * 8.0f * (S_QK * S_QK), 1.0f, qw - key0, lds, o, lsum, X.wave, &lrow);
#pragma unroll
                for (int r = 0; r < 16; ++r) rli[r] = __builtin_amdgcn_rcpf(lrow[r]) * (1.0f / S_V); }
            else {
            att::attn_body<64, 64, 2, true>(SWQ + ((size_t)(b * 16 + hq) * SEQ + qw) * 64, 64, SWK + ((size_t)(b * 4 + kvh) * SEQ + key0) * 64, 64,
                                            SWV + ((size_t)(b * 4 + kvh) * SEQ + key0) * 64, 64, NT, C, THRR, sink[hq] * 8.0f, 1.0f, qw - key0, lds, o, lsum, X.wave);
            att::row_rcp(lsum, lds, 2 * 64 * 64 * 2 + 2 * 64 * 64 * 2, rli, X.wave); }
            GAS bf16_t* ybase = opaque_ptr(YC + (size_t)(b * SEQ + qw + 4 * hi) * 1024 + hq * 64 + r32);
            GAS unsigned char* y8base = opaque_ptr((unsigned char*)YA + (size_t)(b * SEQ + qw + 4 * hi) * 3072 + 2 * 1024 + hq * 64 + r32);
#pragma unroll
            for (int r = 0; r < 16; ++r) { GAS bf16_t* yp = ybase + (size_t)((r & 3) + 8 * (r >> 2)) * 1024; GAS unsigned char* yp8 = y8base + (size_t)((r & 3) + 8 * (r >> 2)) * 3072;
#pragma unroll
                for (int d = 0; d < 2; ++d) { if constexpr (F8B) yp8[32 * d] = fp8_byte(o[d][r] * rli[r] * S_YC); else yp[32 * d] = (bf16_t)(cvt_pk_bf16(o[d][r] * rli[r], 0.f) & 0xffffu); } }
        }
    }
    __syncthreads();
}

constexpr int PH_PER_LAYER = 11, N_PHASES = 1 + DEPTH * PH_PER_LAYER;
__global__ void __launch_bounds__(512, 2) mk_fwd(Args args) {
    extern __shared__ __attribute__((aligned(16))) unsigned char lds_raw[];
    Ctx X;
    X.lds = (LAS unsigned char*)lds_raw; X.ldsg = (char*)lds_raw;
    X.tid = threadIdx.x; X.lane = X.tid & 63; X.wave = __builtin_amdgcn_readfirstlane(X.tid >> 6);
    X.G = gridDim.x; X.gw = blockIdx.x * 8 + X.wave; X.NGW = X.G * 8; X.ws = get_ka()->ws;
    for (int u = X.tid; u < (LDS_BYTES - LDSCTL_OFF) / 4; u += 512) ((LAS unsigned*)(X.lds + LDSCTL_OFF))[u] = 0u;
    __syncthreads();
    unsigned* ctl = (unsigned*)(X.ws + WS_CTL);
    XcdBarrier bar; bar.bar = ctl + CW_BAR; bar.x = 0; bar.st = nullptr;
#if !MK_PER_PHASE
    bar = xcd_barrier_post(ctl + CW_BAR, (volatile LAS unsigned*)(X.lds + L_MISC) + 8);
#endif
    const int lo = get_ka()->ph_lo, hi = get_ka()->ph_hi;
#define IN(k) (lo <= (k) && (k) < hi)
#if MK_PER_PHASE
#define SEAM(k) do { } while (0)
#else
#define SEAM(k) do { if ((k) + 1 < hi) { xcd_barrier(bar); if (((MK_REPEAT) >> 16) & 1u) xcd_barrier(bar); } } while (0)
#endif
    unsigned char* ar; const float* COS; const float* SIN; float* SSQQ; float* SSQK; const float* MOD; bf16_t* H;

#define REFRESH() do { const int t_ = opaque_tid(X.wave); X.tid = t_; X.lane = t_ & 63; \
        { GAS unsigned char* g_ = (GAS unsigned char*)X.ws; asm volatile("" : "+s"(g_)); X.ws = (unsigned char*)g_; }     \
        ar = X.ws + WS_ARENA; COS = (const float*)(X.ws + WS_COS); SIN = (const float*)(X.ws + WS_SIN); SSQQ = (float*)(X.ws + WS_SSQQ); SSQK = (float*)(X.ws + WS_SSQK); \
        MOD = (const float*)(X.ws + WS_MOD); H = (bf16_t*)(X.ws + WS_H); } while (0)
    if (IN(0)) { if constexpr (PHEN(0)) REP(0) { phase_prologue(X, get_ka()); __syncthreads(); } SEAM(0); }

    for (int l = 0; l < DEPTH; ++l) {
        const int pb = 1 + l * PH_PER_LAYER;
#define WB() (X.ws + WS_W + (size_t)l * W_STRIDE)
#define XIN() ((l == 0) ? (const float*)get_ka()->in[0] : (const float*)(X.ws + WS_XCUR))
        if (IN(pb + 0) && l == 0) { REFRESH(); if constexpr (PHEN(1)) phase_ln1(X, XIN(), l); SEAM(pb + 0); }
        if (IN(pb + 1)) { REFRESH();
            pg8::Gemm g{H, (const bf16_t*)(WB() + WO_WIN), F8P ? DM / 2 : DM}; pg8::StaticOrder S; S.init(T, NPROJ, X.G, (int)blockIdx.x);
            pg8::EpiProj E{(bf16_t*)(ar + AR_AQ), (bf16_t*)(ar + AR_AK), (bf16_t*)(ar + AR_AV), (bf16_t*)(ar + AR_CQ), (bf16_t*)(ar + AR_CKV), (bf16_t*)(ar + AR_SWQ), (bf16_t*)(ar + AR_SWK),
                           (bf16_t*)(ar + AR_SWV), (bf16_t*)(ar + AR_GATES), (bf16_t*)(ar + AR_KM), SSQQ, SSQK, COS, SIN};
            if constexpr (PHEN(2)) REP(2) pg8::gemm_phase<pg8::EpiProj, pg8::StaticOrder, F8P, true, true>(X.lds, g, S, E, X.wave);
            { const int nfull = (S.nwg / X.G) * X.G, n6 = S.nwg - nfull;
              if (n6 == 0 || (int)blockIdx.x >= n6) { if (l == 0) convert_range(X, get_ka(), D0_ABC0, D0_ABC1, ((int)blockIdx.x - n6) * 8 + X.wave, (X.G - n6) * 8);
                                                      else convert_range(X, get_ka(), D_UQ1, D_ABC1, ((int)blockIdx.x - n6) * 8 + X.wave, (X.G - n6) * 8); } }
            SEAM(pb + 1);
        }
        if (IN(pb + 2)) { REFRESH();
            { pg8::Gemm g{(const bf16_t*)(ar + AR_CQ), (const bf16_t*)(WB() + WO_WUQ), F8U ? 256 : 512, 1.0f / (64.0f * S_C)}; pg8::StaticOrder S; S.init(T, 1536, X.G, (int)blockIdx.x);
              pg8::EpiUq E{(bf16_t*)(ar + AR_QM), SSQQ, COS, SIN};
              if constexpr (PHEN(3)) REP(3) pg8::gemm_phase<pg8::EpiUq, pg8::StaticOrder, F8U>(X.lds, g, S, E, X.wave); }
            { pg8::Gemm g{(const bf16_t*)(ar + AR_CKV), (const bf16_t*)(WB() + WO_WUKV), F8U ? 128 : 256, 1.0f / (64.0f * S_C)}; pg8::StaticOrder S; S.init(T, 2048, X.G, (int)blockIdx.x);
              pg8::EpiUkv E{(bf16_t*)(ar + AR_KM), (bf16_t*)(ar + AR_VM), SSQK};
              if constexpr (PHEN(4)) REP(3) pg8::gemm_phase<pg8::EpiUkv, pg8::StaticOrder, F8U>(X.lds, g, S, E, X.wave); }
            if (X.G == 256 && (int)blockIdx.x >= 192) { if (l == 0) convert_range(X, get_ka(), D0_ABC1, D0_WOA, ((int)blockIdx.x - 192) * 8 + X.wave, 512);
                                                          else convert_range(X, get_ka(), D_WO1, D_W13A, ((int)blockIdx.x - 192) * 8 + X.wave, 512); }
            else if (X.G != 256) { if (l == 0) convert_range(X, get_ka(), D0_ABC1, D0_WOA, X.gw, X.NGW); else convert_range(X, get_ka(), D_WO1, D_W13A, X.gw, X.NGW); }
            SEAM(pb + 2);
        }
        if (IN(pb + 3)) { REFRESH(); if constexpr (PHEN(5)) phase_attention(X, get_ka(), l); SEAM(pb + 3); }
        if (IN(pb + 4)) { REFRESH();
            pg8::EpiBranch E{(bf16_t*)(ar + AR_Y), (const bf16_t*)(ar + AR_GATES), ar + AR_SCR};
            if constexpr (F8B) { pg8::Gemm g{(const bf16_t*)(ar + AR_YABC), (const bf16_t*)(WB() + WO_WABC), 1536}; pg8::StaticOrder S; S.init(T, DM, X.G, (int)blockIdx.x);
                if constexpr (PHEN(6)) REP(6) pg8::gemm_phase<pg8::EpiBranch, pg8::StaticOrder, true>(X.lds, g, S, E, X.wave); }
            else { pg8::Gemm g{(const bf16_t*)(ar + AR_YABC), (const bf16_t*)(WB() + WO_WABC), 1024}; pg8::BranchOrder S; S.init(T, DM, X.G, (int)blockIdx.x); S.rowsA = T; S.rowsB = DM;
                if constexpr (PHEN(6)) REP(6) { if (X.G == 256) pg8::gemm_phase<pg8::EpiBranch, pg8::BranchOrder, false>(X.lds, g, S, E, X.wave); } }
            SEAM(pb + 4);
        }
        if (IN(pb + 5)) { REFRESH();
            pg8::Gemm g{(const bf16_t*)(ar + (F8B ? AR_SCR : AR_Y)), (const bf16_t*)(WB() + WO_WO), F8B ? DM / 2 : DM, 1.0f / (64.0f * S_Y)}; pg8::StaticOrder S; S.init(T, DM, X.G, (int)blockIdx.x);
            pg8::EpiOut E{(const bf16_t*)(X.ws + WS_XCUR), (bf16_t*)(X.ws + WS_U), MOD + (size_t)(l * 2) * 12288 + 2 * DM};
            if constexpr (PHEN(7)) REP(7) pg8::gemm_phase<pg8::EpiOut, pg8::StaticOrder, F8B>(X.lds, g, S, E, X.wave);
            SEAM(pb + 5);
        }
        if (IN(pb + 6)) { REFRESH(); if constexpr (PHEN(8)) REP(8) phase_ln2_route(X, get_ka(), l); SEAM(pb + 6); }
        if (IN(pb + 8)) { REFRESH();
            if constexpr (PHEN(10)) REP(10) {
            const int nrt = moe_prepare(X, l);
            pg8::Gemm g{(const bf16_t*)(X.ws + WS_H), (const bf16_t*)(WB() + WO_W13), F8M ? DM / 2 : DM};
            pg8::GroupedGatherOrder S{{(const LAS int*)(X.lds + L_TILEEXP), nrt, 4, X.G, (int)blockIdx.x, 1024}, (const LAS int*)(X.lds + L_ROWTOK)};
            pg8::EpiMoeUp E{(bf16_t*)(ar + AR_HID), (const LAS float*)(X.lds + L_ROWGW)};
            pg8::gemm_phase<pg8::EpiMoeUp, pg8::GroupedGatherOrder, F8M, true, true>(X.lds, g, S, E, X.wave);
            { const int n2 = nrt * 4 - X.G > 0 ? nrt * 4 - X.G : 0;
                if ((int)blockIdx.x >= n2 && n2 < X.G) { if (l == 0) convert_range(X, get_ka(), D_WIN0, D_WIN1, ((int)blockIdx.x - n2) * 8 + X.wave, (X.G - n2) * 8); else convert_range(X, get_ka(), D_W20, D_W21, ((int)blockIdx.x - n2) * 8 + X.wave, (X.G - n2) * 8); } } }
            SEAM(pb + 8);
        }
        if (IN(pb + 9)) { REFRESH();
            const int nrt = build_expert_tables(X, l);
            pg8::Gemm g{(const bf16_t*)(ar + AR_HID), (const bf16_t*)(WB() + WO_W2), F8D ? EH / 2 : EH, 1.0f / (64.0f * S_HID)};
            pg8::GroupedOrder S{(const LAS int*)(X.lds + L_TILEEXP), nrt, 8, X.G, (int)blockIdx.x, DM};
            pg8::EpiMoeDown E{(bf16_t*)(ar + AR_OS)};
            if constexpr (PHEN(11)) REP(11) pg8::gemm_phase<pg8::EpiMoeDown, pg8::GroupedOrder, F8D>(X.lds, g, S, E, X.wave);
            if (l == 0) { const int nun = nrt * 8, nfull = (nun / X.G) * X.G, n3 = nun - nfull;
                if (n3 > 0 && (int)blockIdx.x >= n3) { convert_range(X, get_ka(), D_WIN1, D_UQ1, ((int)blockIdx.x - n3) * 8 + X.wave, (X.G - n3) * 8); convert_range(X, get_ka(), D_ABC1, D_WO1, ((int)blockIdx.x - n3) * 8 + X.wave, (X.G - n3) * 8); convert_range(X, get_ka(), D_W13A, D_W13B, ((int)blockIdx.x - n3) * 8 + X.wave, (X.G - n3) * 8); }
                else if (n3 == 0) { convert_range(X, get_ka(), D_WIN1, D_UQ1, X.gw, X.NGW); convert_range(X, get_ka(), D_ABC1, D_WO1, X.gw, X.NGW); convert_range(X, get_ka(), D_W13A, D_W13B, X.gw, X.NGW); } }
            SEAM(pb + 9);
        }
        if (IN(pb + 10)) { REFRESH(); const bool lastl = (l == DEPTH - 1); if constexpr (PHEN(12)) for (int rep_ = 0; rep_ < 1 + (int)((((MK_REPEAT) >> 12) & 1u) && lastl); ++rep_) { if (lastl) phase_final<false>(X, get_ka(), l, get_ka()->out); else phase_final<true>(X, get_ka(), l, (float*)(X.ws + WS_XCUR)); }     SEAM(pb + 10); }
    }
#undef IN
#undef SEAM
}

extern "C" void kernel_launch(void* const* d_in, const int* in_sizes, int n_in, void* d_out, int out_size, void* d_ws, size_t ws_size, hipStream_t stream) {
    static int grid = 0;
    if (grid == 0) {
        if (n_in != 27 || out_size != T * DM || ws_size < WS_END) { fprintf(stderr, "kernel_launch: unexpected shapes (n_in %d, out %d, ws %zu, need %zu)\n", n_in, out_size, ws_size, (size_t)WS_END); grid = -1; return; }
        int dev = 0, cus = 0, per_cu = 0;
        if (hipGetDevice(&dev) != hipSuccess || hipDeviceGetAttribute(&cus, hipDeviceAttributeMultiprocessorCount, dev) != hipSuccess) { grid = -1; return; }
        if (hipFuncSetAttribute((const void*)mk_fwd, hipFuncAttributeMaxDynamicSharedMemorySize, LDS_BYTES) != hipSuccess) { fprintf(stderr, "kernel_launch: hipFuncSetAttribute failed\n"); grid = -1; return; }
        if (hipOccupancyMaxActiveBlocksPerMultiprocessor(&per_cu, (const void*)mk_fwd, 512, LDS_BYTES) != hipSuccess || per_cu < 1) { fprintf(stderr, "kernel_launch: occupancy query says %d\n", per_cu); }
        (void)hipGetLastError();
        grid = cus;
        if (grid != 256) fprintf(stderr, "kernel_launch: %d CUs (the branch phase needs 256)\n", grid);
    }
    if (grid < 0) return;
    (void)hipMemsetAsync((char*)d_ws + WS_CTL, 0, CTL_ZERO_BYTES, stream);
    Args a{};
    for (int i = 0; i < 27; ++i) a.in[i] = d_in[i];
    a.out = (float*)d_out; a.ws = (unsigned char*)d_ws;
#if MK_PER_PHASE
    for (int p = 0; p < N_PHASES; ++p) { a.ph_lo = p; a.ph_hi = p + 1; hipLaunchKernelGGL(mk_fwd, dim3(grid), dim3(512), LDS_BYTES, stream, a); }
#else
    a.ph_lo = 0; a.ph_hi = N_PHASES;
    hipLaunchKernelGGL(mk_fwd, dim3(grid), dim3(512), LDS_BYTES, stream, a);
#endif
}
```
